# Optimizing an MI355X kernel written in HIP

```python
import math
import jax, jax.numpy as jnp
from jax import lax
import numpy as np

D_MODEL = 1024
BATCH = 32
SEQ = 256
DEPTH = 1
DEC_BATCH = 8
DEC_SEQ = 4096
PAST_LEN = 256

GRID_W = 64
N_HEADS_A = 4
HD_A = 64
VD_A = 2 * HD_A
W_A = N_HEADS_A * VD_A
QK_COLS = N_HEADS_A * 2 * HD_A
N_HEADS_R = 8
HD_R = 64
W_R = N_HEADS_R * HD_R
LORA_W = 64
LORA_A = 64
D_FF = int(math.ceil(8 * D_MODEL / 3 / 256)) * 256
ROPE_THETA = 10000.0
Q_BLOCK = 128
EPS_RMS = 1e-6
EPS_GN = 64e-5
SPLIT_SIZES = (QK_COLS, QK_COLS, W_A, W_R, W_R, W_R, W_R, 2 * LORA_W, 2 * LORA_A, 2 * D_MODEL)
SPLIT_POINTS = [int(s) for s in np.cumsum(SPLIT_SIZES)[:-1]]
IN_COLS = int(sum(SPLIT_SIZES))

kernel_name = "diffusion_diffattn_rwkv7_hybrid_step"


def rms_norm(x, w, eps=EPS_RMS):
    xf = x.astype(jnp.float32)
    y = xf * lax.rsqrt(jnp.mean(xf * xf, axis=-1, keepdims=True) + eps)
    return (y * w.astype(jnp.float32)).astype(x.dtype)


def modulation(cond, ada_w, ada_b):
    m = jax.nn.silu(cond) @ ada_w + ada_b
    return jnp.split(m[..., None, :], 6, axis=-1)


def grid_angles(T):
    rows = T // GRID_W
    row = jnp.broadcast_to(jnp.arange(rows)[:, None], (rows, GRID_W)).reshape(-1).astype(jnp.float32)
    col = jnp.broadcast_to(jnp.arange(GRID_W)[None, :], (rows, GRID_W)).reshape(-1).astype(jnp.float32)
    nf = HD_A // 4
    inv = ROPE_THETA ** (-jnp.arange(nf, dtype=jnp.float32) / nf)
    return row[:, None] * inv, col[:, None] * inv


def rope_axial(x, ang_row, ang_col):
    def rot(xh, ang):
        cos = jnp.cos(ang)[None, :, None, None, :].astype(xh.dtype)
        sin = jnp.sin(ang)[None, :, None, None, :].astype(xh.dtype)
        x1, x2 = jnp.split(xh, 2, axis=-1)
        return jnp.concatenate([x1 * cos - x2 * sin, x1 * sin + x2 * cos], axis=-1)
    xr, xc = jnp.split(x, 2, axis=-1)
    return jnp.concatenate([rot(xr, ang_row), rot(xc, ang_col)], axis=-1)


def diff_attention(q, k, v, lam):
    B, Tq = q.shape[0], q.shape[1]
    nb = Tq // Q_BLOCK
    qb = q.reshape(B, nb, Q_BLOCK, N_HEADS_A, 2, HD_A).transpose(1, 0, 2, 3, 4, 5)
    kf = k.astype(jnp.float32)
    vf = v.astype(jnp.float32)
    scale = HD_A ** -0.5

    def block(qblk):
        s = jnp.einsum('bqhmd,bkhmd->bhmqk', qblk.astype(jnp.float32), kf) * scale
        p = jax.nn.softmax(s, axis=-1)
        a = p[:, :, 0] - lam * p[:, :, 1]
        return jnp.einsum('bhqk,bkhe->bqhe', a, vf)

    o = lax.map(block, qb)
    return o.transpose(1, 0, 2, 3, 4).reshape(B, Tq, N_HEADS_A, VD_A)


def rwkv_scan(s0, r, w, kk, b, k, v):
    def to_time(t):
        t = jnp.stack([t[:, 0], jnp.flip(t[:, 1], axis=1)], axis=1)
        return jnp.moveaxis(t, 2, 0)

    def step(S, inp):
        r_t, w_t, kk_t, b_t, k_t, v_t = inp
        sa = jnp.einsum('bzhvk,bzhk->bzhv', S, kk_t)
        S = S * w_t[..., None, :] - sa[..., :, None] * b_t[..., None, :] + v_t[..., :, None] * k_t[..., None, :]
        return S, jnp.einsum('bzhvk,bzhk->bzhv', S, r_t)

    xs = (to_time(r), to_time(w), to_time(kk), to_time(b), to_time(k), to_time(v))
    s_fin, ys = lax.scan(step, s0, xs)
    ys = jnp.moveaxis(ys, 0, 2)
    ys = jnp.stack([ys[:, 0], jnp.flip(ys[:, 1], axis=1)], axis=1)
    return ys, s_fin


def rwkv_mixer(r, k, v, g, wl, al, s0, lp):
    B, T = r.shape[0], r.shape[1]
    f32 = jnp.float32
    dt = r.dtype
    r = r.astype(f32)
    k = k.astype(f32)
    v = v.astype(f32)
    wl = jnp.tanh(wl.astype(f32)).reshape(B, T, 2, LORA_W)
    al = al.astype(f32).reshape(B, T, 2, LORA_A)
    w_log = -jax.nn.softplus(-(lp['w0'][None, :, None, :] + jnp.einsum('btzl,zlc->bztc', wl, lp['w_lora_up']))) - 0.5
    decay = jnp.exp(-jnp.exp(w_log))
    a = jax.nn.sigmoid(lp['a0'][None, :, None, :] + jnp.einsum('btzl,zlc->bztc', al, lp['a_lora_up']))
    kk = (k * lp['k_k']).reshape(B, T, N_HEADS_R, HD_R)
    kk = kk / jnp.maximum(jnp.sqrt(jnp.sum(kk * kk, axis=-1, keepdims=True)), 1e-12)
    kk = jnp.broadcast_to(kk.reshape(B, 1, T, W_R), (B, 2, T, W_R))
    k_d = k[:, None] * (1.0 + (a - 1.0) * lp['k_a'])
    r_b = jnp.broadcast_to(r[:, None], (B, 2, T, W_R))
    v_b = jnp.broadcast_to(v[:, None], (B, 2, T, W_R))

    def heads(t):
        return t.reshape(B, 2, T, N_HEADS_R, HD_R)

    ys, s_fin = rwkv_scan(s0.astype(f32), heads(r_b), heads(decay), heads(kk), heads(kk * a), heads(k_d), heads(v_b))
    y = ys.sum(axis=1)
    mu = jnp.mean(y, axis=-1, keepdims=True)
    var = jnp.mean(jnp.square(y - mu), axis=-1, keepdims=True)
    y = ((y - mu) * lax.rsqrt(var + EPS_GN)).reshape(B, T, W_R) * lp['ln_x_w'] + lp['ln_x_b']
    bonus = (jnp.sum(heads(r_b) * heads(k_d) * lp['r_k'], axis=-1, keepdims=True) * heads(v_b)).sum(axis=1)
    out = (y + bonus.reshape(B, T, W_R)) * jax.nn.sigmoid(g.astype(f32))
    return out.astype(dt), s_fin


def trunk_layer(x, cond, lp, li, ctx_k=None, ctx_v=None, ctx_state=None):
    latent = ctx_k is not None
    B, T, _ = x.shape
    sh1, sc1, g1, sh2, sc2, g2 = modulation(cond, lp['ada_w'], lp['ada_b'])
    h = rms_norm(x, lp['norm1_w']) * (1.0 + sc1) + sh1
    z = h @ lp['w_in']
    q, k, v, rr, kr, vr, gr, wl, al, bg = jnp.split(z, SPLIT_POINTS, axis=-1)

    q = rms_norm(q.reshape(B, T, N_HEADS_A, 2, HD_A), lp['q_norm_w'])
    k = rms_norm(k.reshape(B, T, N_HEADS_A, 2, HD_A), lp['k_norm_w'])
    v = v.reshape(B, T, N_HEADS_A, VD_A)
    own_k, own_v = k, v
    if latent:
        ang_r, ang_c = grid_angles(T)
        q = rope_axial(q, ang_r, ang_c)
        k = jnp.concatenate([ctx_k, rope_axial(k, ang_r, ang_c)], axis=1)
        v = jnp.concatenate([ctx_v, v], axis=1)
        s0 = ctx_state
    else:
        s0 = jnp.zeros((B, 2, N_HEADS_R, HD_R, HD_R), jnp.float32)
    lam_init = 0.8 - 0.6 * math.exp(-0.3 * li)
    f32 = jnp.float32
    lam = (jnp.exp(jnp.sum(lp['lambda_q1'].astype(f32) * lp['lambda_k1'].astype(f32)))
           - jnp.exp(jnp.sum(lp['lambda_q2'].astype(f32) * lp['lambda_k2'].astype(f32))) + lam_init)
    o_a = diff_attention(q, k, v, lam)
    o_a = (rms_norm(o_a, lp['subln_w']) * (1.0 - lam_init)).reshape(B, T, W_A).astype(x.dtype)

    o_r, s_fin = rwkv_mixer(rr, kr, vr, gr, wl, al, s0, lp)

    gate_a, gate_r = jnp.split(jax.nn.sigmoid(bg), 2, axis=-1)
    merged = gate_a * (o_a @ lp['w_attn_br']) + gate_r * (o_r @ lp['w_rwkv_br'])
    x = x + g1 * (merged @ lp['w_out'])

    h2 = rms_norm(x, lp['norm2_w']) * (1.0 + sc2) + sh2
    u, gt = jnp.split(h2 @ lp['w_ffn_in'], 2, axis=-1)
    x = x + g2 * ((jax.nn.silu(u) * gt) @ lp['w_ffn_out'])
    return x, own_k, own_v, s_fin


def setup_inputs(seed: int = 0) -> dict:
    key = jax.random.key(seed)
    ks = iter(jax.random.split(key, 48))

    def nrm(shape, scale):
        return jax.random.normal(next(ks), shape, jnp.float32) * scale

    L = DEPTH
    return {
        'x_prompt': nrm((BATCH, SEQ, D_MODEL), 1.0),
        'x_sample': nrm((DEC_BATCH, DEC_SEQ, D_MODEL), 1.0),
        'cache_k': nrm((DEC_BATCH, L, PAST_LEN, N_HEADS_A, 2, HD_A), 1.0),
        'cache_v': nrm((DEC_BATCH, L, PAST_LEN, N_HEADS_A, VD_A), 1.0),
        'state_rwkv': nrm((DEC_BATCH, L, 2, N_HEADS_R, HD_R, HD_R), 1.0),
        'c': nrm((DEC_BATCH, D_MODEL), 1.0),
        'c_ctx': nrm((D_MODEL,), 1.0),
        'ada_w': nrm((L, D_MODEL, 6 * D_MODEL), 0.5 * D_MODEL ** -0.5),
        'ada_b': nrm((L, 6 * D_MODEL), 0.02),
        'norm1_w': 1.0 + nrm((L, D_MODEL), 0.02),
        'norm2_w': 1.0 + nrm((L, D_MODEL), 0.02),
        'w_in': nrm((L, D_MODEL, IN_COLS), D_MODEL ** -0.5),
        'q_norm_w': 1.0 + nrm((L, HD_A), 0.02),
        'k_norm_w': 1.0 + nrm((L, HD_A), 0.02),
        'lambda_q1': nrm((L, HD_A), 0.1),
        'lambda_k1': nrm((L, HD_A), 0.1),
        'lambda_q2': nrm((L, HD_A), 0.1),
        'lambda_k2': nrm((L, HD_A), 0.1),
        'subln_w': 1.0 + nrm((L, VD_A), 0.02),
        'w_lora_up': nrm((L, 2, LORA_W, W_R), 0.1),
        'w0': jax.random.uniform(next(ks), (L, 2, W_R), jnp.float32, minval=-5.0, maxval=0.5),
        'a_lora_up': nrm((L, 2, LORA_A, W_R), 0.1),
        'a0': nrm((L, 2, W_R), 0.1),
        'k_k': 0.85 + nrm((L, W_R), 0.02),
        'k_a': 1.0 + nrm((L, W_R), 0.02),
        'r_k': nrm((L, N_HEADS_R, HD_R), 0.1),
        'ln_x_w': 1.0 + nrm((L, W_R), 0.02),
        'ln_x_b': nrm((L, W_R), 0.02),
        'w_attn_br': nrm((L, W_A, D_MODEL), W_A ** -0.5),
        'w_rwkv_br': nrm((L, W_R, D_MODEL), W_R ** -0.5),
        'w_out': nrm((L, D_MODEL, D_MODEL), D_MODEL ** -0.5),
        'w_ffn_in': nrm((L, D_MODEL, 2 * D_FF), D_MODEL ** -0.5),
        'w_ffn_out': nrm((L, D_FF, D_MODEL), D_FF ** -0.5),
    }


def reference(x_prompt, x_sample, cache_k, cache_v, state_rwkv, c, c_ctx, ada_w, ada_b, norm1_w, norm2_w,
              w_in, q_norm_w, k_norm_w, lambda_q1, lambda_k1, lambda_q2, lambda_k2, subln_w, w_lora_up, w0,
              a_lora_up, a0, k_k, k_a, r_k, ln_x_w, ln_x_b, w_attn_br, w_rwkv_br, w_out, w_ffn_in, w_ffn_out):
    y_prompt = x_prompt
    y_sample = x_sample
    ks_out, vs_out, ss_out = [], [], []
    for li in range(DEPTH):
        lp = {
            'ada_w': ada_w[li], 'ada_b': ada_b[li], 'norm1_w': norm1_w[li], 'norm2_w': norm2_w[li],
            'w_in': w_in[li], 'q_norm_w': q_norm_w[li], 'k_norm_w': k_norm_w[li],
            'lambda_q1': lambda_q1[li], 'lambda_k1': lambda_k1[li], 'lambda_q2': lambda_q2[li],
            'lambda_k2': lambda_k2[li], 'subln_w': subln_w[li], 'w_lora_up': w_lora_up[li], 'w0': w0[li],
            'a_lora_up': a_lora_up[li], 'a0': a0[li], 'k_k': k_k[li], 'k_a': k_a[li], 'r_k': r_k[li],
            'ln_x_w': ln_x_w[li], 'ln_x_b': ln_x_b[li], 'w_attn_br': w_attn_br[li], 'w_rwkv_br': w_rwkv_br[li],
            'w_out': w_out[li], 'w_ffn_in': w_ffn_in[li], 'w_ffn_out': w_ffn_out[li],
        }
        y_prompt, k_c, v_c, s_c = trunk_layer(y_prompt, c_ctx, lp, li)
        ks_out.append(k_c)
        vs_out.append(v_c)
        ss_out.append(s_c)
        y_sample, _, _, _ = trunk_layer(y_sample, c, lp, li, cache_k[:, li], cache_v[:, li], state_rwkv[:, li])
    new_k = jnp.stack(ks_out, axis=1)
    new_v = jnp.stack(vs_out, axis=1)
    new_state = jnp.stack(ss_out, axis=1)
    return (y_prompt, y_sample, new_k, new_v, new_state)
```

```cpp
#include <hip/hip_runtime.h>
#include <hip/hip_cooperative_groups.h>
#include <cstdio>
#include <cstdint>
namespace cg = cooperative_groups;
namespace pg8 {
#define PG8_LAS __attribute__((address_space(3)))
typedef unsigned short bf16_t;
typedef short bf16x8 __attribute__((ext_vector_type(8)));
typedef float f32x4 __attribute__((ext_vector_type(4)));
typedef unsigned u32x4 __attribute__((ext_vector_type(4)));
constexpr int BM = 256, BK = 64, HALF = 128, HTB = HALF * BK * 2  , STAGE_BYTES = 8 * HTB, NXCD = 8, WGM = 8;

__host__ __device__ __forceinline__ int lds_byte(int r, int c) { const int st = (r >> 4) * 2 + (c >> 5), rr = r & 15, cc = c & 31, ob = rr * 64 + cc * 2; return st * 1024 + (ob ^ (((ob >> 9) & 1) << 5)); }
__host__ __device__ __forceinline__ void stage_rc(int b, int& R, int& C) { const int st = b / 1024, sb = b % 1024, swz = sb ^ (((sb >> 9) & 1) << 5); R = (st >> 1) * 16 + swz / 64; C = (st & 1) * 32 + (swz % 64) / 2; }
__host__ __device__ __forceinline__ int perm32(int rho) { const int n = rho >> 4, i = rho & 15; return 8 * (i >> 2) + 4 * n + (i & 3); }

struct Unit { int pm, pn; };
struct Gemm { const bf16_t* A; const bf16_t* Bt; int M, N, K; };

struct StaticOrder {
    int nM, nN, nwg, G, c;
    __host__ __device__ void init(int M, int N, int G_, int c_) { nM = M / BM; nN = N / BM; nwg = nM * nN; G = G_; c = c_; }
    __host__ __device__ bool next(int i, Unit& u) const {
        const long L = (long)i * G + c; if (L >= nwg) return false;
        int wgid = (int)L; { const int q = nwg / NXCD, r = nwg % NXCD, xcd = wgid % NXCD, off = wgid / NXCD; wgid = (xcd < r ? xcd * (q + 1) : r * (q + 1) + (xcd - r) * q) + off; }
        const int nig = WGM * nN, gid = wgid / nig, fm = gid * WGM, gsz = (nM - fm) < WGM ? (nM - fm) : WGM;
        u.pm = fm + ((wgid % nig) % gsz); u.pn = (wgid % nig) / gsz; return true;
    }
    __device__ __forceinline__ void a_ready(const Unit&) const {}
    __device__ __forceinline__ void done(const Unit&) const {}
};
__device__ __forceinline__ unsigned cvt_pk_bf16(float lo, float hi) { unsigned r; asm volatile("v_cvt_pk_bf16_f32 %0, %1, %2" : "=v"(r) : "v"(lo), "v"(hi)); return r; }
typedef float f32x2 __attribute__((ext_vector_type(2)));
template <class Epi, class Sched, bool ALIGN_EPI = false, bool SP2 = false>
__device__ __forceinline__ void gemm_phase(PG8_LAS unsigned char* lds, const Gemm g, const Sched& S, const Epi& E) {
    const int tid = threadIdx.x, wid = __builtin_amdgcn_readfirstlane(tid >> 6), lane = tid & 63, wr = wid >> 2, wc = wid & 3, fr = lane & 15, fq = lane >> 4;
    const int K = g.K, nt = K / BK;
    unsigned voffA[2], voffB[2];
#pragma unroll
    for (int i = 0; i < 2; ++i) { int R, C; stage_rc(tid * 16 + i * 8192, R, C); const int Rb = Epi::PERM ? ((R & ~31) + perm32(R & 31)) : R;
        voffA[i] = (unsigned)(R * K + C) * 2u; voffB[i] = (unsigned)(Rb * K + C) * 2u; }
    const size_t kstep = (size_t)(BK * 2);
    const size_t hstep = (size_t)HALF * K * 2;
    const size_t tstep = 2 * hstep;
    const unsigned ldsw = (unsigned)wid * 1024u;
    const int aoff = lds_byte(wr * 64 + fr, fq * 8), boff = lds_byte(wc * 32 + fr, fq * 8);
#define PG8_SA(b, h) (((b) * 2 + (h)) * HTB)
#define PG8_SB(b, h) ((4 + (b) * 2 + (h)) * HTB)
#define PG8_STAGE(bufoff, gbase, voff) do { _Pragma("unroll") for (int _i = 0; _i < 2; ++_i) \
        __builtin_amdgcn_global_load_lds((const unsigned*)((const char*)(gbase) + (voff)[_i]), (PG8_LAS unsigned*)(lds + (bufoff) + ldsw + _i * 8192), 16, 0, 0); } while (0)
#define PG8_LDA(dst, b, h) do { _Pragma("unroll") for (int m = 0; m < 4; ++m) _Pragma("unroll") for (int k = 0; k < 2; ++k) dst[m][k] = *(const PG8_LAS bf16x8*)(lds + PG8_SA(b, h) + aoff + m * 2048 + k * 1024); } while (0)
#define PG8_LDB(dst, b, h) do { _Pragma("unroll") for (int n = 0; n < 2; ++n) _Pragma("unroll") for (int k = 0; k < 2; ++k) dst[n][k] = *(const PG8_LAS bf16x8*)(lds + PG8_SB(b, h) + boff + n * 2048 + k * 1024); } while (0)
#define PG8_MMA(ai, bj, At, Bt) do { __builtin_amdgcn_s_setprio(1); _Pragma("unroll") for (int m = 0; m < 4; ++m) _Pragma("unroll") for (int n = 0; n < 2; ++n) _Pragma("unroll") for (int k = 0; k < 2; ++k) \
        acc[ai][bj][m][n] = __builtin_amdgcn_mfma_f32_16x16x32_bf16(Bt[n][k], At[m][k], acc[ai][bj][m][n], 0, 0, 0); __builtin_amdgcn_s_setprio(0); } while (0)
#define PG8_WAIT_V(n) asm volatile("s_waitcnt vmcnt(" #n ")" ::: "memory")
#define PG8_WAIT_L(n) asm volatile("s_waitcnt lgkmcnt(" #n ")" ::: "memory")
#define PG8_BAR __builtin_amdgcn_s_barrier()
#define PG8_SCHED __builtin_amdgcn_sched_barrier(0)
    Unit cur, nxt; int ui = 0;
    if (!S.next(0, cur)) return;
    f32x4 acc[2][2][4][2];
#pragma unroll
    for (int a = 0; a < 2; ++a)
#pragma unroll
        for (int b = 0; b < 2; ++b)
#pragma unroll
            for (int m = 0; m < 4; ++m)
#pragma unroll
                for (int n = 0; n < 2; ++n) acc[a][b][m][n] = (f32x4){0.f, 0.f, 0.f, 0.f};
    bf16x8 At[4][2], B0[2][2], B1[2][2];
    const char* cA = (const char*)g.A + (size_t)cur.pm * tstep; const char* cB = (const char*)g.Bt + (size_t)cur.pn * tstep;
    S.a_ready(cur);
    if constexpr (SP2) {
        PG8_STAGE(PG8_SB(0, 0), cB, voffB); PG8_STAGE(PG8_SB(0, 1), cB + hstep, voffB); PG8_STAGE(PG8_SA(0, 0), cA, voffA); PG8_STAGE(PG8_SA(0, 1), cA + hstep, voffA);
        if (wr == 1) PG8_BAR;
        PG8_WAIT_V(2); PG8_BAR;
        PG8_STAGE(PG8_SB(1, 0), cB + kstep, voffB); PG8_STAGE(PG8_SA(1, 0), cA + kstep, voffA); PG8_STAGE(PG8_SB(1, 1), cB + hstep + kstep, voffB);
        PG8_WAIT_V(6); PG8_BAR;
    } else {
        PG8_STAGE(PG8_SB(0, 0), cB, voffB); PG8_STAGE(PG8_SA(0, 0), cA, voffA); PG8_STAGE(PG8_SB(0, 1), cB + hstep, voffB); PG8_STAGE(PG8_SA(0, 1), cA + hstep, voffA);
        if (wr == 1) PG8_BAR;
        PG8_WAIT_V(4); PG8_BAR;
        PG8_STAGE(PG8_SB(1, 0), cB + kstep, voffB); PG8_STAGE(PG8_SA(1, 0), cA + kstep, voffA); PG8_STAGE(PG8_SB(1, 1), cB + hstep + kstep, voffB);
        PG8_WAIT_V(6); PG8_BAR;
    }
    for (;;) {
        const bool has_next = S.next(ui + 1, nxt);
        const char* nA = has_next ? (const char*)g.A + (size_t)nxt.pm * tstep : cA; const char* nB = has_next ? (const char*)g.Bt + (size_t)nxt.pn * tstep : cB;
        for (int t = 0; t < nt; t += 2) {
            if constexpr (Epi::MIDK) { if (t == nt / 2) E.mid(acc, cur, wr, wc, fr, fq); }
            const bool last = (t == nt - 2);
            const char* a1 = cA + (size_t)(t + 1) * kstep;
            const char* a2 = last ? nA : cA + (size_t)(t + 2) * kstep; const char* b2 = last ? nB : cB + (size_t)(t + 2) * kstep;
            const char* a3 = a2 + kstep; const char* b3 = b2 + kstep;
            if (last && has_next) S.a_ready(nxt);
            if constexpr (SP2) {
            PG8_LDB(B0, 0, 0); PG8_LDB(B1, 0, 1); PG8_SCHED; PG8_LDA(At, 0, 0); PG8_STAGE(PG8_SA(1, 1), a1 + hstep, voffA);
            PG8_WAIT_V(8); PG8_WAIT_L(0); PG8_BAR; PG8_MMA(0, 0, At, B0); PG8_MMA(0, 1, At, B1); PG8_BAR; PG8_SCHED;
            PG8_LDA(At, 0, 1); PG8_STAGE(PG8_SB(0, 0), b2, voffB); PG8_STAGE(PG8_SB(0, 1), b2 + hstep, voffB); PG8_STAGE(PG8_SA(0, 0), a2, voffA);
            PG8_WAIT_V(8); PG8_WAIT_L(0); PG8_BAR; PG8_MMA(1, 0, At, B0); PG8_MMA(1, 1, At, B1); PG8_BAR; PG8_SCHED;
            PG8_LDB(B0, 1, 0); PG8_LDB(B1, 1, 1); PG8_SCHED; PG8_LDA(At, 1, 0); PG8_STAGE(PG8_SA(0, 1), a2 + hstep, voffA);
            PG8_WAIT_V(8); PG8_WAIT_L(0); PG8_BAR; PG8_MMA(0, 0, At, B0); PG8_MMA(0, 1, At, B1); PG8_BAR; PG8_SCHED;
            PG8_LDA(At, 1, 1); PG8_STAGE(PG8_SB(1, 0), b3, voffB); PG8_STAGE(PG8_SB(1, 1), b3 + hstep, voffB); PG8_STAGE(PG8_SA(1, 0), a3, voffA);
            PG8_WAIT_V(8); PG8_WAIT_L(0); PG8_BAR; PG8_MMA(1, 0, At, B0); PG8_MMA(1, 1, At, B1); PG8_BAR; PG8_SCHED;
            } else {
            PG8_LDB(B0, 0, 0); PG8_SCHED; PG8_LDA(At, 0, 0); PG8_STAGE(PG8_SA(1, 1), a1 + hstep, voffA);
            PG8_WAIT_L(8); PG8_BAR; PG8_WAIT_L(0); PG8_MMA(0, 0, At, B0); PG8_BAR; PG8_SCHED;
            PG8_LDB(B1, 0, 1); PG8_STAGE(PG8_SB(0, 0), b2, voffB);
            PG8_BAR; PG8_WAIT_L(0); PG8_MMA(0, 1, At, B1); PG8_BAR;
            PG8_LDA(At, 0, 1); PG8_STAGE(PG8_SA(0, 0), a2, voffA);
            PG8_BAR; PG8_WAIT_L(0); PG8_MMA(1, 0, At, B0); PG8_BAR; PG8_SCHED;
            PG8_STAGE(PG8_SB(0, 1), b2 + hstep, voffB);
            PG8_WAIT_V(6); PG8_BAR; PG8_MMA(1, 1, At, B1); PG8_BAR;
            PG8_LDB(B0, 1, 0); PG8_SCHED; PG8_LDA(At, 1, 0); PG8_STAGE(PG8_SA(0, 1), a2 + hstep, voffA);
            PG8_WAIT_L(8); PG8_BAR; PG8_WAIT_L(0); PG8_MMA(0, 0, At, B0); PG8_BAR; PG8_SCHED;
            PG8_LDB(B1, 1, 1); PG8_STAGE(PG8_SB(1, 0), b3, voffB);
            PG8_BAR; PG8_WAIT_L(0); PG8_MMA(0, 1, At, B1); PG8_BAR;
            PG8_LDA(At, 1, 1); PG8_STAGE(PG8_SA(1, 0), a3, voffA);
            PG8_BAR; PG8_WAIT_L(0); PG8_MMA(1, 0, At, B0); PG8_BAR; PG8_SCHED;
            PG8_STAGE(PG8_SB(1, 1), b3 + hstep, voffB);
            PG8_WAIT_V(6); PG8_BAR; PG8_MMA(1, 1, At, B1); PG8_BAR;
            }
        }
        if constexpr (ALIGN_EPI) { if (wr == 0) PG8_BAR; }
        if constexpr (!Epi::AFTER_DRAIN) { E(acc, cur, wr, wc, fr, fq); S.done(cur); }
        if (!has_next) break;
#pragma unroll
        for (int a = 0; a < 2; ++a)
#pragma unroll
            for (int b = 0; b < 2; ++b)
#pragma unroll
                for (int m = 0; m < 4; ++m)
#pragma unroll
                    for (int n = 0; n < 2; ++n) acc[a][b][m][n] = (f32x4){0.f, 0.f, 0.f, 0.f};
        cur = nxt; cA = nA; cB = nB; ++ui;
        if constexpr (ALIGN_EPI) { if (wr == 1) PG8_BAR; }
    }
    PG8_WAIT_V(0);
    if constexpr (!ALIGN_EPI) { if (wr == 0) PG8_BAR; }
    PG8_BAR;
    if constexpr (Epi::AFTER_DRAIN) { E.fused(acc, cur, wr, wc, fr, fq, lds, wid, lane); S.done(cur); }
#undef PG8_SA
#undef PG8_SB
#undef PG8_STAGE
#undef PG8_LDA
#undef PG8_LDB
#undef PG8_MMA
#undef PG8_WAIT_V
#undef PG8_WAIT_L
#undef PG8_BAR
#undef PG8_SCHED
}
}
using pg8::bf16_t; using pg8::f32x4; using pg8::Unit;
typedef short bf16x8 __attribute__((ext_vector_type(8)));
typedef float f32x16 __attribute__((ext_vector_type(16)));
typedef float f32x2_t __attribute__((ext_vector_type(2)));
typedef __bf16 bf16x2_t __attribute__((ext_vector_type(2)));
typedef unsigned u32x2 __attribute__((ext_vector_type(2)));
typedef unsigned u32x4 __attribute__((ext_vector_type(4)));
#define DI __device__ __forceinline__

constexpr int M_TOK = 40960, M_CTX = 8192;
constexpr float LOG2E = 1.4426950408889634f;

constexpr size_t al256(size_t x) { return (x + 255) & ~(size_t)255; }
constexpr size_t OFF_CTL = 0;
constexpr size_t OFF_KMAX = 2048;
constexpr size_t OFF_MOD = 4096;
constexpr size_t OFF_QKW = 1024;
constexpr size_t OFF_WINT = al256(OFF_MOD + 9 * 6144 * 4);
constexpr size_t OFF_WAT = OFF_WINT + (size_t)5888 * 1024 * 2;
constexpr size_t OFF_WRT = OFF_WAT + (size_t)1024 * 512 * 2;
constexpr size_t OFF_WOT = OFF_WRT + (size_t)1024 * 512 * 2;
constexpr size_t OFF_WFIT = OFF_WOT + (size_t)1024 * 1024 * 2;
constexpr size_t OFF_WFOT = OFF_WFIT + (size_t)5632 * 1024 * 2;
constexpr size_t OFF_WUPT = OFF_WFOT + (size_t)1024 * 2816 * 2;
constexpr size_t OFF_BS = OFF_WUPT + (size_t)4 * 512 * 64 * 2;
constexpr size_t OFF_H1 = al256(OFF_BS + (size_t)2 * M_TOK * 8 * 4);
constexpr size_t OFF_QB = OFF_H1 + (size_t)M_TOK * 1024 * 2;
constexpr size_t OFF_OA = OFF_QB + (size_t)M_TOK * 512 * 2;
constexpr size_t OFF_KC = OFF_OA + (size_t)M_TOK * 512 * 2;
constexpr size_t OFF_KL = OFF_KC + (size_t)32 * 256 * 512 * 2;
constexpr size_t OFF_VTC = OFF_KL + (size_t)8 * 4352 * 512 * 2;
constexpr size_t OFF_VTL = OFF_VTC + (size_t)32 * 4 * 128 * 256 * 2;
constexpr size_t OFF_R = OFF_VTL + (size_t)8 * 4 * 128 * 4352 * 2;
constexpr size_t OFF_KR = OFF_R + (size_t)M_TOK * 512 * 2;
constexpr size_t OFF_VR = OFF_KR + (size_t)M_TOK * 512 * 2;
constexpr size_t OFF_GR = OFF_VR + (size_t)M_TOK * 512 * 2;
constexpr size_t OFF_WLAL = OFF_GR + (size_t)M_TOK * 512 * 2;
constexpr size_t OFF_T2X = OFF_WLAL + (size_t)M_TOK * 256 * 2;
constexpr size_t OFF_XBAR = al256(OFF_T2X);
constexpr size_t WS_END = OFF_XBAR + 3456 * 4;
constexpr size_t OFF_OR = OFF_QB;
constexpr size_t OFF_T2 = OFF_R;
constexpr size_t OFF_MERGED = OFF_KC;
constexpr size_t OFF_ACT = OFF_QB;
constexpr size_t OFF_X1B = OFF_R + ((size_t)64 << 20);
static_assert(OFF_ACT + (size_t)M_TOK * 2816 * 2 <= OFF_X1B && OFF_X1B + (size_t)M_TOK * 1024 * 2 <= OFF_WLAL, "x1 placement");
static_assert(OFF_MERGED + (size_t)M_TOK * 1024 * 2 <= OFF_R, "merged overlay");
static_assert(OFF_ACT + (size_t)M_TOK * 2816 * 2 <= OFF_WLAL, "act overlay");
constexpr size_t OUT_Y = 0, OUT_NEWK = (size_t)M_TOK * 1024, OUT_NEWV = OUT_NEWK + (size_t)M_CTX * 512, OUT_STATE = OUT_NEWV + (size_t)M_CTX * 512;
constexpr int LDS_BYTES = 131072 + 256;

struct Params { const float* in[33]; float* out; unsigned char* ws; unsigned long long ws_size; };

DI float bf2f(unsigned short v) { return __uint_as_float(((unsigned)v) << 16); }
DI unsigned cvtpk(float lo, float hi) { f32x2_t v = {lo, hi}; bf16x2_t b = __builtin_convertvector(v, bf16x2_t); return __builtin_bit_cast(unsigned, b); }
DI unsigned short f2bf(float f) { return (unsigned short)(cvtpk(f, 0.f) & 0xffffu); }
DI float sigmoidf_(float x) { return __builtin_amdgcn_rcpf(1.0f + __builtin_amdgcn_exp2f(-x * LOG2E)); }
DI float tanhf_(float x) { return 1.0f - 2.0f * __builtin_amdgcn_rcpf(__builtin_amdgcn_exp2f(2.0f * LOG2E * x) + 1.0f); }
DI void store_bf4(bf16_t* p, float a, float b, float c, float d) { u32x2 w; w.x = cvtpk(a, b); w.y = cvtpk(c, d); *(u32x2*)p = w; }
DI void store_bf8(bf16_t* p, const f32x4 a, const f32x4 b) { u32x4 w; w.x = cvtpk(a[0], a[1]); w.y = cvtpk(a[2], a[3]); w.z = cvtpk(b[0], b[1]); w.w = cvtpk(b[2], b[3]); *(u32x4*)p = w; }
DI int cond_of_row(int row) { return row < M_CTX ? 8 : ((row - M_CTX) >> 12); }

DI int perm8(int p32) { return ((p32 >> 2) & 3) * 8 + (p32 >> 4) * 4 + (p32 & 3); }
DI int colmap(int mode, int n) {
    if (mode == 1) { if (n < 1024) { const int p = n & 255; return (n & ~255) + 64 * ((p >> 5) & 3) + 32 * (p >> 7) + (p & 31); }
                     if (n >= 1536) return (n & ~31) + perm8(n & 31);
                     return n; }
    if (mode == 2) { const int j = n >> 8, r = n & 255, q = (r & ~31) + perm8(r & 31); return (q < 128) ? 128 * j + q : 2816 + 128 * j + (q - 128); }
    if (mode == 3) return (n & ~31) + perm8(n & 31);
    return n;
}
DI void transpose_load(const float* src, int src_ld, int k0, int n0, int mode, float* tile) {
    const int tid = threadIdx.x, j = tid & 63, i0 = tid >> 6; const int sc = colmap(mode, n0 + j);
#pragma unroll
    for (int ps = 0; ps < 8; ++ps) { const int i = i0 + 8 * ps; tile[i * 65 + j] = src[(size_t)(k0 + i) * src_ld + sc]; }
}
DI void transpose_store(bf16_t* dst, int dst_ld, int k0, int n0, const float* tile) {
    const int tid = threadIdx.x, ii = tid & 63, j0 = tid >> 6;
#pragma unroll
    for (int ps = 0; ps < 8; ++ps) { const int jj = j0 + 8 * ps; dst[(size_t)(n0 + jj) * dst_ld + k0 + ii] = f2bf(tile[ii * 65 + jj]); }
}
struct TTask { const float* src; bf16_t* dst; int src_ld, dst_ld, k0, n0, mode; };
DI TTask transpose_task(const Params& p, int t) {
    TTask q; q.mode = 0;
    if (t < 1472) { q.src = p.in[11]; q.src_ld = 5888; q.dst = (bf16_t*)(p.ws + OFF_WINT); q.dst_ld = 1024; q.k0 = (t & 15) * 64; q.n0 = (t >> 4) * 64; q.mode = 1; }
    else if ((t -= 1472) < 128) { q.src = p.in[28]; q.src_ld = 1024; q.mode = 3; q.dst = (bf16_t*)(p.ws + OFF_WAT); q.dst_ld = 1024; q.k0 = (t & 7) * 64; q.n0 = (t >> 3) * 64; }
    else if ((t -= 128) < 128) { q.src = p.in[29]; q.src_ld = 1024; q.mode = 3; q.dst = (bf16_t*)(p.ws + OFF_WAT) + 512; q.dst_ld = 1024; q.k0 = (t & 7) * 64; q.n0 = (t >> 3) * 64; }
    else if ((t -= 128) < 256) { q.src = p.in[30]; q.src_ld = 1024; q.mode = 3; q.dst = (bf16_t*)(p.ws + OFF_WOT); q.dst_ld = 1024; q.k0 = (t & 15) * 64; q.n0 = (t >> 4) * 64; }
    else if ((t -= 256) < 1408) { q.src = p.in[31]; q.src_ld = 5632; q.dst = (bf16_t*)(p.ws + OFF_WFIT); q.dst_ld = 1024; q.k0 = (t & 15) * 64; q.n0 = (t >> 4) * 64; q.mode = 2; }
    else if ((t -= 1408) < 704) { q.src = p.in[32]; q.src_ld = 1024; q.mode = 3; q.dst = (bf16_t*)(p.ws + OFF_WFOT); q.dst_ld = 2816; q.k0 = (t % 44) * 64; q.n0 = (t / 44) * 64; }
    else if ((t -= 704) < 32) { const int tz = t >> 3; q.src = (tz >= 2 ? p.in[21] : p.in[19]) + (size_t)(tz & 1) * 64 * 512; q.src_ld = 512; q.dst = (bf16_t*)(p.ws + OFF_WUPT) + (size_t)tz * 512 * 64; q.dst_ld = 64; q.k0 = 0; q.n0 = (t & 7) * 64; }
    else { t -= 32; const int bh = t >> 3, b = bh >> 2, h = bh & 3; q.src = p.in[3] + (size_t)b * 256 * 512 + h * 128; q.src_ld = 512; q.dst = (bf16_t*)(p.ws + OFF_VTL) + (size_t)bh * 128 * 4352; q.dst_ld = 4352; q.k0 = (t & 3) * 64; q.n0 = ((t >> 2) & 1) * 64; }
    return q;
}
DI void phase_prep(const Params& p, unsigned char* ldsg) {
    const int tid = threadIdx.x;
    float* sl = (float*)ldsg;
    float* red = sl + 9216;
    for (int i = tid; i < 9216; i += 512) { const int c = i >> 10, k = i & 1023; const float v = (c < 8) ? p.in[5][c * 1024 + k] : p.in[6][k]; sl[i] = v * sigmoidf_(v); }
    __syncthreads();
    float* MOD = (float*)(p.ws + OFF_MOD);
    if (blockIdx.x == 0) {
        for (int i = tid; i < 1024; i += 512) ((unsigned*)(p.ws + OFF_CTL))[i] = 0u;
        for (int i = tid; i < 3456; i += 512) ((unsigned*)(p.ws + OFF_XBAR))[i] = 0u;
        __syncthreads();
        if (tid < 128) ((float*)(p.ws + OFF_QKW))[tid] = tid < 64 ? p.in[12][tid] : p.in[13][tid - 64]; }
    const float* ada_w = p.in[7]; const float* ada_b = p.in[8];
    for (int cc = blockIdx.x; cc < 256; cc += gridDim.x) {
        const int col = tid % 24, kg = tid / 24;
        float acc[9];
#pragma unroll
        for (int c = 0; c < 9; ++c) acc[c] = 0.f;
        if (tid < 504) {
            for (int k = kg; k < 1024; k += 21) { const float w = ada_w[(size_t)k * 6144 + cc * 24 + col];
#pragma unroll
                for (int c = 0; c < 9; ++c) acc[c] += sl[c * 1024 + k] * w; }
#pragma unroll
            for (int c = 0; c < 9; ++c) red[(kg * 24 + col) * 9 + c] = acc[c];
        }
        __syncthreads();
        if (tid < 216) { const int c = tid / 24, cl = tid % 24; float s = ada_b[cc * 24 + cl];
            for (int g = 0; g < 21; ++g) s += red[(g * 24 + cl) * 9 + c];
            MOD[c * 6144 + cc * 24 + cl] = s; }
        __syncthreads();
    }
    float* tile = (float*)ldsg;
    for (int task = blockIdx.x; task < 4384; task += 4 * gridDim.x) {
        TTask q[4];
#pragma unroll
        for (int e = 0; e < 4; ++e) { const int t = task + e * gridDim.x; if (t < 4384) { q[e] = transpose_task(p, t); transpose_load(q[e].src, q[e].src_ld, q[e].k0, q[e].n0, q[e].mode, tile + e * 4160); } }
        __syncthreads();
#pragma unroll
        for (int e = 0; e < 4; ++e) { const int t = task + e * gridDim.x; if (t < 4384) transpose_store(q[e].dst, q[e].dst_ld, q[e].k0, q[e].n0, tile + e * 4160); }
        __syncthreads();
    }
}

DI void phase_cachek(const Params& p) {
    const int tid = threadIdx.x;
    { bf16_t* KL = (bf16_t*)(p.ws + OFF_KL); const float* ck = p.in[2];
      for (int i = blockIdx.x * 512 + tid; i < 8 * 256 * 128; i += gridDim.x * 512) {
          const int b = i >> 15, rem = i & 32767, t = rem >> 7, c4 = rem & 127;
          const f32x4 v = *(const f32x4*)(ck + (size_t)i * 4);
          store_bf4(KL + ((size_t)b * 4352 + t) * 512 + c4 * 4, v[0], v[1], v[2], v[3]);
          float ss = v[0] * v[0] + v[1] * v[1] + v[2] * v[2] + v[3] * v[3];
          ss += __shfl_xor(ss, 1); ss += __shfl_xor(ss, 2); ss += __shfl_xor(ss, 4); ss += __shfl_xor(ss, 8);
          if ((c4 & 15) == 0) atomicMax((unsigned*)(p.ws + OFF_KMAX) + b * 8 + (c4 >> 4), __float_as_uint(ss * 1.02f)); } }
}

template <bool BF16IN> DI void phase_norm(const float* xa, const float* xb, const bf16_t* xh, const float* nw, const float* MOD, int sh_idx, int sc_idx, bf16_t* H) {
    const int tid = threadIdx.x, lane = tid & 63, wid = __builtin_amdgcn_readfirstlane(tid >> 6);
    const int gw = blockIdx.x * 8 + wid, nwv = gridDim.x * 8;
    const int rpw = (M_TOK + nwv - 1) / nwv; const int r0 = gw * rpw; int r1 = r0 + rpw; if (r1 > M_TOK) r1 = M_TOK;
    int cur = -1; f32x4 scl[4], shf[4];
#pragma unroll
    for (int j = 0; j < 4; ++j) { scl[j] = (f32x4){0.f, 0.f, 0.f, 0.f}; shf[j] = scl[j]; }
    for (int row = r0; row < r1; row += 4) {
        f32x4 v[4][4];
#pragma unroll
        for (int q = 0; q < 4; ++q) { const int rr = (row + q < r1) ? row + q : r1 - 1;
            if (BF16IN) {
#pragma unroll
                for (int jj = 0; jj < 2; ++jj) { const u32x4 w = *(const u32x4*)(xh + (size_t)rr * 1024 + 8 * lane + 512 * jj);
                    v[q][2 * jj] = (f32x4){__uint_as_float(w.x << 16), __uint_as_float(w.x & 0xffff0000u), __uint_as_float(w.y << 16), __uint_as_float(w.y & 0xffff0000u)};
                    v[q][2 * jj + 1] = (f32x4){__uint_as_float(w.z << 16), __uint_as_float(w.z & 0xffff0000u), __uint_as_float(w.w << 16), __uint_as_float(w.w & 0xffff0000u)}; }
            } else { const float* x = rr < M_CTX ? xa + (size_t)rr * 1024 : xb + (size_t)(rr - M_CTX) * 1024;
#pragma unroll
                for (int j = 0; j < 4; ++j) v[q][j] = *(const f32x4*)(x + 8 * lane + 512 * (j >> 1) + 4 * (j & 1)); } }
#pragma unroll
        for (int q = 0; q < 4; ++q) { const int rr = (row + q < r1) ? row + q : r1 - 1;
            const int cid = cond_of_row(rr);
            if (cid != cur) { cur = cid;
#pragma unroll
                for (int j = 0; j < 4; ++j) { const int col = 8 * lane + 512 * (j >> 1) + 4 * (j & 1);
                    const f32x4 w = *(const f32x4*)(nw + col), sc = *(const f32x4*)(MOD + cid * 6144 + sc_idx * 1024 + col);
                    scl[j] = w * (sc + 1.0f); shf[j] = *(const f32x4*)(MOD + cid * 6144 + sh_idx * 1024 + col); } }
            float ss = 0.f;
#pragma unroll
            for (int j = 0; j < 4; ++j) ss += v[q][j][0] * v[q][j][0] + v[q][j][1] * v[q][j][1] + v[q][j][2] * v[q][j][2] + v[q][j][3] * v[q][j][3];
#pragma unroll
            for (int o = 32; o >= 1; o >>= 1) ss += __shfl_xor(ss, o);
            const float rs = rsqrtf(ss * (1.0f / 1024.0f) + 1e-6f);
#pragma unroll
            for (int jj = 0; jj < 2; ++jj) store_bf8(H + (size_t)rr * 1024 + 8 * lane + 512 * jj, v[q][2 * jj] * rs * scl[2 * jj] + shf[2 * jj], v[q][2 * jj + 1] * rs * scl[2 * jj + 1] + shf[2 * jj + 1]);
        }
    }
}
#define XB_TMO      128
#define XB_XCNT(j)  (256  + 64 * (j))
#define XB_XSUB(j)  (1280 + 64 * (j))
#define XB_XGEN(j)  (2304 + 64 * (j))
#define XB_TOP      3328
#define XB_TOPGEN   3392
#define XCD_BAR_WORDS 3456
#define XB_SPIN_CAP (1u << 18)
#define XLAS __attribute__((address_space(3)))
__device__ __forceinline__ unsigned xb_ld(unsigned* p)              { return __hip_atomic_load(p, __ATOMIC_RELAXED, __HIP_MEMORY_SCOPE_AGENT); }
__device__ __forceinline__ unsigned xb_add(unsigned* p, unsigned v) { return __hip_atomic_fetch_add(p, v, __ATOMIC_RELAXED, __HIP_MEMORY_SCOPE_AGENT); }
__device__ __forceinline__ unsigned xb_xcc_id() { return (unsigned)__builtin_amdgcn_s_getreg((3 << 11) | 20) & 0xFu; }
#define XB_SPIN(cond, bar) do { unsigned _sp = 0; while (cond) { __builtin_amdgcn_s_sleep(1); \
    if ((++_sp & 255u) == 0u) { if (xb_ld(&(bar)[XB_TMO])) break; if (_sp > XB_SPIN_CAP) { atomicAdd(&(bar)[XB_TMO], 1u); break; } } } } while (0)

struct XcdBarrier {
    unsigned* bar; unsigned x;
    volatile XLAS unsigned* st;
};

__device__ __forceinline__ XcdBarrier xcd_barrier_post(unsigned* bar, volatile XLAS unsigned* st) {
    XcdBarrier b; b.bar = bar; b.x = xb_xcc_id(); b.st = st;
    if (threadIdx.x == 0) (void)xb_add(&bar[XB_XCNT(b.x)], 1u);
    return b;
}
__device__ __forceinline__ void xcd_barrier_complete(unsigned* bar, unsigned x, unsigned& nloc, unsigned& nx) {
    const unsigned G = gridDim.x * gridDim.y * gridDim.z;
    unsigned sum, cnt, mine, sp = 0u;
    for (;;) {
        sum = 0u; cnt = 0u; mine = 0u;
#pragma unroll
        for (unsigned j = 0; j < 16; ++j) { const unsigned c = xb_ld(&bar[XB_XCNT(j)]); sum += c; cnt += (c > 0u) ? 1u : 0u; mine = (j == x) ? c : mine; }
        if (sum == G) break;
        __builtin_amdgcn_s_sleep(1);
        if ((++sp & 255u) == 0u) { if (xb_ld(&bar[XB_TMO])) break; if (sp > XB_SPIN_CAP) { atomicAdd(&bar[XB_TMO], 1u); break; } }
    }
    nloc = mine > 0u ? mine : 1u; nx = cnt > 0u ? cnt : 1u;
}

__device__ __forceinline__ void xcd_barrier(const XcdBarrier& b) {
    asm volatile("s_waitcnt vmcnt(0)" ::: "memory");
    __syncthreads();
    if (threadIdx.x == 0) {
        unsigned* bar = b.bar;
        __builtin_amdgcn_s_waitcnt(0);
        unsigned nloc = b.st[0], nx = b.st[1];
        if (nloc == 0u) { xcd_barrier_complete(bar, b.x, nloc, nx); b.st[0] = nloc; b.st[1] = nx; }
        const unsigned old = xb_add(&bar[XB_XSUB(b.x)], 1u);
        const unsigned gen = old / nloc;
        if (old + 1u == (gen + 1u) * nloc) {
            __builtin_amdgcn_fence(__ATOMIC_RELEASE, "agent");
            asm volatile("s_waitcnt vmcnt(0)" ::: "memory");
            const unsigned og = xb_add(&bar[XB_TOP], 1u);
            const unsigned tg = og / nx;
            if (og + 1u == (tg + 1u) * nx) xb_add(&bar[XB_TOPGEN], 1u);
            else XB_SPIN(xb_ld(&bar[XB_TOPGEN]) == tg, bar);
            __builtin_amdgcn_fence(__ATOMIC_ACQUIRE, "agent");
            xb_add(&bar[XB_XGEN(b.x)], 1u);
            asm volatile("s_waitcnt vmcnt(0)" ::: "memory");
        } else {
            XB_SPIN(xb_ld(&bar[XB_XGEN(b.x)]) == gen, bar);
            __builtin_amdgcn_fence(__ATOMIC_ACQUIRE, "agent");
            asm volatile("s_waitcnt vmcnt(0)" ::: "memory");
        }
    }
    __syncthreads();
}

struct Epi1 {
    static constexpr bool PERM = false, AFTER_DRAIN = false, MIDK = false;
    unsigned char* ws; float* out;
    __device__ __forceinline__ void operator()(const f32x4 (&acc)[2][2][4][2], const Unit& u, int wr, int wc, int fr, int fq) const {
        asm volatile("" : "+v"(fr), "+v"(fq));
        const int pn = u.pn, pm = u.pm; const bool ctx = pm < 32;
        bf16_t* const Qb = (bf16_t*)(ws + OFF_QB); bf16_t* const KC = (bf16_t*)(ws + OFF_KC); bf16_t* const KL = (bf16_t*)(ws + OFF_KL);
        bf16_t* const VtC = (bf16_t*)(ws + OFF_VTC); bf16_t* const VtL = (bf16_t*)(ws + OFF_VTL); bf16_t* const R = (bf16_t*)(ws + OFF_R); bf16_t* const WLAL = (bf16_t*)(ws + OFF_WLAL);
        float* const newk = out + OUT_NEWK; float* const newv = out + OUT_NEWV;
        const int lr0 = wr * 64 + fr;
        const int bL = ctx ? 0 : ((pm - 32) >> 4), tL0 = ctx ? 0 : ((pm - 32) & 15) * 256;
        if (pn < 4) {
            const bool isk = pn >= 2; const float* nw = (const float*)(ws + OFF_QKW) + (isk ? 64 : 0);
            f32x4 nwv[2][2];
#pragma unroll
            for (int bj = 0; bj < 2; ++bj)
#pragma unroll
                for (int n = 0; n < 2; ++n) nwv[bj][n] = *(const f32x4*)(nw + 32 * bj + 16 * n + 4 * fq);
            float inv[4];
#pragma unroll
            for (int e = 0; e < 4; ++e) inv[e] = __builtin_amdgcn_exp2f(-(float)(4 * fq + e) * 0.830482023721841f);
            const int colbase = 256 * (pn & 1) + 64 * wc + 4 * fq;
            float kmx = 0.f;
#pragma unroll
            for (int ai = 0; ai < 2; ++ai)
#pragma unroll
                for (int m = 0; m < 4; ++m) {
                    const int lr = lr0 + ai * 128 + m * 16;
                    float ss = 0.f;
#pragma unroll
                    for (int bj = 0; bj < 2; ++bj)
#pragma unroll
                        for (int n = 0; n < 2; ++n) { const f32x4 x = acc[ai][bj][m][n]; ss += x[0] * x[0] + x[1] * x[1] + x[2] * x[2] + x[3] * x[3]; }
                    ss += __shfl_xor(ss, 16); ss += __shfl_xor(ss, 32);
                    const float rs = rsqrtf(ss * (1.0f / 64.0f) + 1e-6f);
                    f32x4 val[2][2];
#pragma unroll
                    for (int bj = 0; bj < 2; ++bj)
#pragma unroll
                        for (int n = 0; n < 2; ++n) val[bj][n] = acc[ai][bj][m][n] * rs * nwv[bj][n];
                    if (!ctx) {
                        const int t = tL0 + lr;
#pragma unroll
                        for (int bj = 0; bj < 2; ++bj) { const float pos = (float)(bj ? (t & 63) : (t >> 6));
#pragma unroll
                            for (int e = 0; e < 4; ++e) { const float ang = pos * inv[e]; const float sn = __sinf(ang), cs = __cosf(ang);
                                const float x1 = val[bj][0][e], x2 = val[bj][1][e]; val[bj][0][e] = x1 * cs - x2 * sn; val[bj][1][e] = x1 * sn + x2 * cs; } }
                    }
                    const size_t row = (size_t)pm * 256 + lr;
                    if (isk) { float s2 = 0.f;
#pragma unroll
                        for (int bj = 0; bj < 2; ++bj)
#pragma unroll
                            for (int n = 0; n < 2; ++n) { const f32x4 v = val[bj][n]; s2 += v[0] * v[0] + v[1] * v[1] + v[2] * v[2] + v[3] * v[3]; }
                        s2 += __shfl_xor(s2, 16); s2 += __shfl_xor(s2, 32);
                        kmx = fmaxf(kmx, s2); }
#pragma unroll
                    for (int bj = 0; bj < 2; ++bj)
#pragma unroll
                        for (int n = 0; n < 2; ++n) { const int col = colbase + 32 * bj + 16 * n; const f32x4 v = val[bj][n];
                            if (!isk) store_bf4(Qb + row * 512 + col, v[0], v[1], v[2], v[3]);
                            else if (ctx) { store_bf4(KC + row * 512 + col, v[0], v[1], v[2], v[3]); *(f32x4*)(newk + row * 512 + col) = v; }
                            else store_bf4(KL + ((size_t)bL * 4352 + 256 + tL0 + lr) * 512 + col, v[0], v[1], v[2], v[3]); }
                    asm volatile("" ::: "memory"); __builtin_amdgcn_sched_barrier(0);
                }
            if (isk) {
                kmx = fmaxf(kmx, __shfl_xor(kmx, 1)); kmx = fmaxf(kmx, __shfl_xor(kmx, 2)); kmx = fmaxf(kmx, __shfl_xor(kmx, 4)); kmx = fmaxf(kmx, __shfl_xor(kmx, 8));
                if (fr == 0 && fq == 0) { const int hm = 4 * (pn & 1) + wc;
                    atomicMax((unsigned*)(ws + OFF_KMAX) + (ctx ? 64 + pm * 8 : bL * 8) + hm, __float_as_uint(kmx * 1.02f)); }
            }
        } else if (pn < 6) {
#pragma unroll
            for (int ai = 0; ai < 2; ++ai)
#pragma unroll
                for (int m = 0; m < 4; ++m) { const int lr = lr0 + ai * 128 + m * 16; const size_t row = (size_t)pm * 256 + lr;
#pragma unroll
                    for (int bj = 0; bj < 2; ++bj) { const int h = 2 * (pn - 4) + bj;
#pragma unroll
                        for (int n = 0; n < 2; ++n) { const int d0 = 32 * wc + 16 * n + 4 * fq; const f32x4 v = acc[ai][bj][m][n];
                            if (ctx) { bf16_t* vp = VtC + ((size_t)(pm * 4 + h) * 128 + d0) * 256 + lr;
#pragma unroll
                                for (int e = 0; e < 4; ++e) vp[(size_t)e * 256] = f2bf(v[e]);
                                *(f32x4*)(newv + row * 512 + 256 * (pn - 4) + 128 * bj + d0) = v; }
                            else { bf16_t* vp = VtL + ((size_t)(bL * 4 + h) * 128 + d0) * 4352 + 256 + tL0 + lr;
#pragma unroll
                                for (int e = 0; e < 4; ++e) vp[(size_t)e * 4352] = f2bf(v[e]); } } }
                    asm volatile("" ::: "memory"); __builtin_amdgcn_sched_barrier(0); }
        } else if (pn < 14) {
            const int which = (pn - 6) >> 1; bf16_t* dst = R + (size_t)which * M_TOK * 512;
            const int cb = 256 * ((pn - 6) & 1) + 32 * wc + 8 * fq;
#pragma unroll
            for (int ai = 0; ai < 2; ++ai)
#pragma unroll
                for (int m = 0; m < 4; ++m) { const size_t row = (size_t)pm * 256 + lr0 + ai * 128 + m * 16;
#pragma unroll
                    for (int bj = 0; bj < 2; ++bj) {
                        if (which == 3) {
                            f32x4 t0 = acc[ai][bj][m][0], t1 = acc[ai][bj][m][1];
#pragma unroll
                            for (int e = 0; e < 4; ++e) { t0[e] = sigmoidf_(t0[e]) * 255.0f + 0.5f; t1[e] = sigmoidf_(t1[e]) * 255.0f + 0.5f; }
                            u32x2 w; w.x = (unsigned)t0[0] | ((unsigned)t0[1] << 8) | ((unsigned)t0[2] << 16) | ((unsigned)t0[3] << 24);
                            w.y = (unsigned)t1[0] | ((unsigned)t1[1] << 8) | ((unsigned)t1[2] << 16) | ((unsigned)t1[3] << 24);
                            *(u32x2*)((unsigned char*)dst + row * 512 + cb + 128 * bj) = w;
                        } else store_bf8(dst + row * 512 + cb + 128 * bj, acc[ai][bj][m][0], acc[ai][bj][m][1]); }
                    asm volatile("" ::: "memory"); __builtin_amdgcn_sched_barrier(0); }
        } else if (pn == 14) {
            const int cb = 32 * wc + 8 * fq;
#pragma unroll
            for (int ai = 0; ai < 2; ++ai)
#pragma unroll
                for (int m = 0; m < 4; ++m) { const size_t row = (size_t)pm * 256 + lr0 + ai * 128 + m * 16;
                    { f32x4 t0 = acc[ai][0][m][0], t1 = acc[ai][0][m][1];
#pragma unroll
                      for (int e = 0; e < 4; ++e) { t0[e] = tanhf_(t0[e]); t1[e] = tanhf_(t1[e]); }
                      store_bf8(WLAL + row * 256 + cb, t0, t1); store_bf8(WLAL + row * 256 + 128 + cb, acc[ai][1][m][0], acc[ai][1][m][1]); }
                    asm volatile("" ::: "memory"); __builtin_amdgcn_sched_barrier(0); }
        } else {
            unsigned char* const G = (unsigned char*)out; const int cb = 256 * (pn - 15) + 32 * wc + 8 * fq;
#pragma unroll
            for (int ai = 0; ai < 2; ++ai)
#pragma unroll
                for (int m = 0; m < 4; ++m) { const size_t row = (size_t)pm * 256 + lr0 + ai * 128 + m * 16;
#pragma unroll
                    for (int bj = 0; bj < 2; ++bj) { f32x4 t0 = acc[ai][bj][m][0], t1 = acc[ai][bj][m][1];
#pragma unroll
                        for (int e = 0; e < 4; ++e) { t0[e] = sigmoidf_(t0[e]) * 255.0f + 0.5f; t1[e] = sigmoidf_(t1[e]) * 255.0f + 0.5f; }
                        u32x2 w; w.x = (unsigned)t0[0] | ((unsigned)t0[1] << 8) | ((unsigned)t0[2] << 16) | ((unsigned)t0[3] << 24);
                        w.y = (unsigned)t1[0] | ((unsigned)t1[1] << 8) | ((unsigned)t1[2] << 16) | ((unsigned)t1[3] << 24);
                        *(u32x2*)(G + row * 2048 + cb + 128 * bj) = w; }
                    asm volatile("" ::: "memory"); __builtin_amdgcn_sched_barrier(0); }
        }
    }
};
struct EpiMerge1 {
    static constexpr bool PERM = false, AFTER_DRAIN = false, MIDK = true;
    const unsigned char* G; bf16_t* MG;
    __device__ __forceinline__ void mid(f32x4 (&acc)[2][2][4][2], const Unit& u, int wr, int wc, int fr, int fq) const {
        asm volatile("" : "+v"(fr), "+v"(fq));
        const int row0 = u.pm * 256 + wr * 64 + fr, col0 = u.pn * 256 + wc * 32 + 8 * fq;
#pragma unroll
        for (int ai = 0; ai < 2; ++ai)
#pragma unroll
            for (int m = 0; m < 4; ++m) { const unsigned char* gp = G + (size_t)(row0 + ai * 128 + m * 16) * 2048 + col0;
#pragma unroll
                for (int bj = 0; bj < 2; ++bj) { const u32x2 ga = *(const u32x2*)(gp + bj * 128), gr = *(const u32x2*)(gp + 1024 + bj * 128);
#pragma unroll
                    for (int n = 0; n < 2; ++n)
#pragma unroll
                        for (int e = 0; e < 4; ++e) { const float a = (float)(((n ? ga.y : ga.x) >> (8 * e)) & 255u), r = fmaxf((float)(((n ? gr.y : gr.x) >> (8 * e)) & 255u), 1.0f);
                            acc[ai][bj][m][n][e] *= a * __builtin_amdgcn_rcpf(r); } }
                asm volatile("" ::: "memory"); }
    }
    __device__ __forceinline__ void operator()(const f32x4 (&acc)[2][2][4][2], const Unit& u, int wr, int wc, int fr, int fq) const {
        asm volatile("" : "+v"(fr), "+v"(fq));
        const int row0 = u.pm * 256 + wr * 64 + fr, col0 = u.pn * 256 + wc * 32 + 8 * fq;
#pragma unroll
        for (int ai = 0; ai < 2; ++ai)
#pragma unroll
            for (int m = 0; m < 4; ++m) { const size_t row = (size_t)(row0 + ai * 128 + m * 16);
#pragma unroll
                for (int bj = 0; bj < 2; ++bj) { const u32x2 gr = *(const u32x2*)(G + row * 2048 + 1024 + col0 + bj * 128);
                    f32x4 o[2];
#pragma unroll
                    for (int n = 0; n < 2; ++n)
#pragma unroll
                        for (int e = 0; e < 4; ++e) o[n][e] = acc[ai][bj][m][n][e] * (fmaxf((float)(((n ? gr.y : gr.x) >> (8 * e)) & 255u), 1.0f) * (1.0f / 255.0f));
                    store_bf8(MG + row * 1024 + col0 + bj * 128, o[0], o[1]); }
                asm volatile("" ::: "memory"); }
    }
};
template <int MODE> struct EpiResid {
    static constexpr bool PERM = false, AFTER_DRAIN = false, MIDK = false;
    const float *xa, *xb; float* out; const float* MOD; int gidx; bf16_t* X1b;
    __device__ __forceinline__ void operator()(const f32x4 (&acc)[2][2][4][2], const Unit& u, int wr, int wc, int fr, int fq) const {
        asm volatile("" : "+v"(fr), "+v"(fq));
        const int row0 = u.pm * 256 + wr * 64 + fr, col0 = u.pn * 256 + wc * 32 + 8 * fq;
        const int cid = u.pm < 32 ? 8 : ((u.pm - 32) >> 4);
        f32x4 g[2][2];
#pragma unroll
        for (int bj = 0; bj < 2; ++bj)
#pragma unroll
            for (int n = 0; n < 2; ++n) g[bj][n] = *(const f32x4*)(MOD + cid * 6144 + gidx * 1024 + col0 + bj * 128 + n * 4);
#pragma unroll
        for (int ai = 0; ai < 2; ++ai)
#pragma unroll
            for (int m = 0; m < 4; ++m) { const int row = row0 + ai * 128 + m * 16; const size_t off = (size_t)row * 1024 + col0;
                const float* xs = u.pm < 32 ? xa + off : xb + (off - (size_t)M_CTX * 1024);
#pragma unroll
                for (int bj = 0; bj < 2; ++bj) { const size_t o2 = off + bj * 128;
                    if (MODE == 0) { const f32x4 x0 = *(const f32x4*)(xs + bj * 128), x1 = *(const f32x4*)(xs + bj * 128 + 4);
                        store_bf8(X1b + o2, x0 + g[bj][0] * acc[ai][bj][m][0], x1 + g[bj][1] * acc[ai][bj][m][1]); }
                    else { const u32x4 w = *(const u32x4*)(X1b + o2);
                        const f32x4 x0 = {__uint_as_float(w.x << 16), __uint_as_float(w.x & 0xffff0000u), __uint_as_float(w.y << 16), __uint_as_float(w.y & 0xffff0000u)};
                        const f32x4 x1 = {__uint_as_float(w.z << 16), __uint_as_float(w.z & 0xffff0000u), __uint_as_float(w.w << 16), __uint_as_float(w.w & 0xffff0000u)};
                        *(f32x4*)(out + o2) = x0 + g[bj][0] * acc[ai][bj][m][0]; *(f32x4*)(out + o2 + 4) = x1 + g[bj][1] * acc[ai][bj][m][1]; } } }
    }
};
struct EpiSwiGLU {
    static constexpr bool PERM = false, AFTER_DRAIN = false, MIDK = false;
    bf16_t* ACT;
    __device__ __forceinline__ void operator()(const f32x4 (&acc)[2][2][4][2], const Unit& u, int wr, int wc, int fr, int fq) const {
        asm volatile("" : "+v"(fr), "+v"(fq));
        const int row0 = u.pm * 256 + wr * 64 + fr, col0 = u.pn * 128 + wc * 32 + 8 * fq;
#pragma unroll
        for (int ai = 0; ai < 2; ++ai)
#pragma unroll
            for (int m = 0; m < 4; ++m) { bf16_t* rp = ACT + (size_t)(row0 + ai * 128 + m * 16) * 2816 + col0;
                f32x4 t[2];
#pragma unroll
                for (int n = 0; n < 2; ++n) { const f32x4 a = acc[ai][0][m][n], g = acc[ai][1][m][n];
#pragma unroll
                    for (int e = 0; e < 4; ++e) t[n][e] = a[e] * sigmoidf_(a[e]) * g[e]; }
                store_bf8(rp, t[0], t[1]); }
    }
};
template <int CTRL> DI float dpp_add(float x) { const int y = __builtin_amdgcn_update_dpp(0, __float_as_int(x), CTRL, 0xF, 0xF, true); return x + __int_as_float(y); }
DI float red16(float x) { x = dpp_add<0xB1>(x); x = dpp_add<0x4E>(x); x = dpp_add<0x141>(x); x = dpp_add<0x140>(x); return x; }
DI float dot4(const f32x4 a, const f32x4 b) { return (a[0] * b[0] + a[1] * b[1]) + (a[2] * b[2] + a[3] * b[3]); }

#define LBAR() do { asm volatile("s_waitcnt lgkmcnt(0)" ::: "memory"); __builtin_amdgcn_s_barrier(); asm volatile("" ::: "memory"); } while (0)
#define RDL(x, l) __int_as_float(__builtin_amdgcn_readlane(__float_as_int(x), (l)))
DI bf16x8 ldfrag(const bf16_t* base, int row, int pitch, int col) { return *(const bf16x8*)(base + row * pitch + col); }
DI void scan_chain(const Params& p, unsigned char* ldsg, bool latent, int b, int z, int h) {
    int tid = threadIdx.x; asm volatile("" : "+v"(tid));
    const int lane = tid & 63, wid = __builtin_amdgcn_readfirstlane(tid >> 6), l15 = lane & 15, quad = lane >> 4;
    const int T = latent ? 4096 : 256, rowbase = latent ? M_CTX + b * 4096 : b * 256, nchunk = T >> 5;
    float* AW0 = (float*)ldsg; float* AW1 = AW0 + 2048; float* CUM = AW0 + 4096;
    bf16_t* KKt = (bf16_t*)(ldsg + 24576);
    bf16_t* S0b = (bf16_t*)(ldsg + 43008);
    bf16_t* VT = (bf16_t*)(ldsg + 52224);
    bf16_t* KDT = (bf16_t*)(ldsg + 57344);
    bf16_t* BBT = (bf16_t*)(ldsg + 62464);
    bf16_t* A1T = (bf16_t*)(ldsg + 67584);
    float* A2f = (float*)(ldsg + 75264);
    float* RHSf = (float*)(ldsg + 79360);
    bf16_t* Ub = (bf16_t*)(ldsg + 88576);
    float* CL = (float*)(ldsg + 93696);
    const bf16_t* R = (const bf16_t*)(p.ws + OFF_R); const bf16_t* Kr = (const bf16_t*)(p.ws + OFF_KR); const bf16_t* Vr = (const bf16_t*)(p.ws + OFF_VR);
    const bf16_t* WLAL = (const bf16_t*)(p.ws + OFF_WLAL); const bf16_t* WUPT = (const bf16_t*)(p.ws + OFF_WUPT);
    float* BS = (float*)(p.ws + OFF_BS); bf16_t* Y = (bf16_t*)(p.ws + OFF_H1);
    const int type = wid >> 2, ntile = wid & 3;
    bf16x8 bw[2];
#pragma unroll
    for (int ks = 0; ks < 2; ++ks) bw[ks] = *(const bf16x8*)(WUPT + ((size_t)(type * 2 + z) * 512 + h * 64 + ntile * 16 + l15) * 64 + ks * 32 + quad * 8);
    const float bias0 = (type == 0 ? p.in[20] : p.in[22])[z * 512 + h * 64 + ntile * 16 + l15];
    const int te = tid >> 4, c4 = (tid & 15) * 4, hc = h * 64 + c4;
    const f32x4 kkc = *(const f32x4*)(p.in[23] + hc), kac = *(const f32x4*)(p.in[24] + hc), rkc = *(const f32x4*)(p.in[25] + hc);
    const int vt = wid >> 1, kt0 = 2 * (wid & 1);
    f32x4 S[2];
#pragma unroll
    for (int q = 0; q < 2; ++q)
#pragma unroll
        for (int j = 0; j < 4; ++j) { const int v = vt * 16 + quad * 4 + j, k = (kt0 + q) * 16 + l15;
            S[q][j] = latent ? p.in[4][((size_t)((b * 2 + z) * 8 + h)) * 4096 + v * 64 + k] : 0.f;
            S0b[v * 72 + k] = f2bf(S[q][j]); }
    bf16x8 af[2][2]; u32x2 kreg, rreg, vreg;
#define SCAN_TOK(idx) (rowbase + (z ? (T - 1 - (idx)) : (idx)))
    const long cstep = z ? -32 : 32;
    const bf16_t* pw0 = WLAL + (size_t)SCAN_TOK(l15) * 256 + type * 128 + z * 64 + quad * 8;
    const bf16_t* pw1 = WLAL + (size_t)SCAN_TOK(16 + l15) * 256 + type * 128 + z * 64 + quad * 8;
    const bf16_t* pk = Kr + (size_t)SCAN_TOK(te) * 512 + hc;
    const long offR = (long)(R - Kr), offV = (long)(Vr - Kr);
#define SCAN_PREFETCH(n) do { \
        af[0][0] = *(const bf16x8*)(pw0); af[0][1] = *(const bf16x8*)(pw0 + 32); af[1][0] = *(const bf16x8*)(pw1); af[1][1] = *(const bf16x8*)(pw1 + 32); \
        kreg = *(const u32x2*)(pk); rreg = *(const u32x2*)(pk + offR); vreg = *(const u32x2*)(pk + offV); \
        pw0 += cstep * 256; pw1 += cstep * 256; pk += cstep * 512; } while (0)
    SCAN_PREFETCH(0);
    for (int n = 0; n < nchunk; ++n) {
        int L15 = l15, QD = quad, TE = te, C4 = c4, LN = lane;
        asm volatile("" : "+v"(L15), "+v"(QD), "+v"(TE), "+v"(C4), "+v"(LN));
        { float Lv[2][4];
#pragma unroll
          for (int mt = 0; mt < 2; ++mt) { f32x4 acc = {0.f, 0.f, 0.f, 0.f};
              acc = __builtin_amdgcn_mfma_f32_16x16x32_bf16(af[mt][0], bw[0], acc, 0, 0, 0);
              acc = __builtin_amdgcn_mfma_f32_16x16x32_bf16(af[mt][1], bw[1], acc, 0, 0, 0);
#pragma unroll
              for (int j = 0; j < 4; ++j) { const float sg = sigmoidf_(acc[j] + bias0); Lv[mt][j] = type == 0 ? -0.6065306597126334f * LOG2E * sg : sg; } }
          if (type == 0) {
              float base = 0.f;
#pragma unroll
              for (int mt = 0; mt < 2; ++mt) {
                  const float p0 = Lv[mt][0], p1 = p0 + Lv[mt][1], p2 = p1 + Lv[mt][2], p3 = p2 + Lv[mt][3];
                  float sq = p3;
                  const float u1 = __shfl_up(sq, 16); if (QD >= 1) sq += u1;
                  const float u2 = __shfl_up(sq, 32); if (QD >= 2) sq += u2;
                  const float ex = base + (sq - p3);
                  const int idx = (mt * 16 + QD * 4) * 64 + ntile * 16 + L15;
                  AW0[idx] = Lv[mt][0]; AW0[idx + 64] = Lv[mt][1]; AW0[idx + 128] = Lv[mt][2]; AW0[idx + 192] = Lv[mt][3];
                  CUM[idx] = ex + p0; CUM[idx + 64] = ex + p1; CUM[idx + 128] = ex + p2; CUM[idx + 192] = ex + p3;
                  base += __shfl(sq, 48 + L15);
              }
          } else {
#pragma unroll
              for (int mt = 0; mt < 2; ++mt)
#pragma unroll
                  for (int j = 0; j < 4; ++j) AW1[(mt * 16 + QD * 4 + j) * 64 + ntile * 16 + L15] = Lv[mt][j];
          } }
        LBAR();
        { const int tok = SCAN_TOK(n * 32 + TE);
          float kv[4], rv[4];
          kv[0] = __uint_as_float(kreg.x << 16); kv[1] = __uint_as_float(kreg.x & 0xffff0000u); kv[2] = __uint_as_float(kreg.y << 16); kv[3] = __uint_as_float(kreg.y & 0xffff0000u);
          rv[0] = __uint_as_float(rreg.x << 16); rv[1] = __uint_as_float(rreg.x & 0xffff0000u); rv[2] = __uint_as_float(rreg.y << 16); rv[3] = __uint_as_float(rreg.y & 0xffff0000u);
          float qv[4]; float ss = 0.f;
#pragma unroll
          for (int e = 0; e < 4; ++e) { qv[e] = kv[e] * kkc[e]; ss += qv[e] * qv[e]; }
          ss = red16(ss);
          const float invn = rsqrtf(fmaxf(ss, 1e-24f));
          const f32x4 aa = *(const f32x4*)(AW1 + TE * 64 + C4), Lw = *(const f32x4*)(AW0 + TE * 64 + C4), Lc = *(const f32x4*)(CUM + TE * 64 + C4);
          float KKv[4], RRv[4], KDv[4], BBv[4], ctv[4]; float bon = 0.f;
#pragma unroll
          for (int e = 0; e < 4; ++e) { const float ct = __builtin_amdgcn_exp2f(Lc[e]), cprev = __builtin_amdgcn_exp2f(Lc[e] - Lw[e]), ic = __builtin_amdgcn_exp2f(-Lc[e]);
              const float kn = qv[e] * invn, bb = kn * aa[e], kd = kv[e] * (1.0f + (aa[e] - 1.0f) * kac[e]);
              bon += rv[e] * kd * rkc[e];
              KKv[e] = kn * cprev; RRv[e] = rv[e] * ct; KDv[e] = kd * ic; BBv[e] = bb * ic;
              ctv[e] = ct; }
          if (TE == 31) *(f32x4*)(CL + C4) = (f32x4){ctv[0], ctv[1], ctv[2], ctv[3]};
          bon = red16(bon);
          if ((tid & 15) == 0) BS[((size_t)z * M_TOK + tok) * 8 + h] = bon;
          store_bf4(KKt + TE * 72 + C4, KKv[0], KKv[1], KKv[2], KKv[3]); store_bf4(KKt + 2304 + TE * 72 + C4, RRv[0], RRv[1], RRv[2], RRv[3]);
          store_bf4(KKt + 4608 + TE * 72 + C4, KDv[0], KDv[1], KDv[2], KDv[3]); store_bf4(KKt + 6912 + TE * 72 + C4, BBv[0], BBv[1], BBv[2], BBv[3]);
#pragma unroll
          for (int e = 0; e < 4; ++e) { KDT[(C4 + e) * 40 + TE] = f2bf(KDv[e]); BBT[(C4 + e) * 40 + TE] = f2bf(-BBv[e]); }
          VT[(C4 + 0) * 40 + TE] = (bf16_t)(vreg.x & 0xffffu); VT[(C4 + 1) * 40 + TE] = (bf16_t)(vreg.x >> 16); VT[(C4 + 2) * 40 + TE] = (bf16_t)(vreg.y & 0xffffu); VT[(C4 + 3) * 40 + TE] = (bf16_t)(vreg.y >> 16); }
        if (n + 1 < nchunk) SCAN_PREFETCH(n + 1);
        LBAR();
        f32x4 P[2];
        { const int am = wid >> 1;
          const bf16_t* X = KKt + 4608 + (am & 1) * 2304; const bf16_t* Yt = KKt + (am >> 1) * 2304;
          bf16_t* AT = A1T + (am == 0 ? 0 : am == 2 ? 1280 : 2560);
          const bool strict = am < 2; const float sgn = am == 3 ? -1.0f : 1.0f;
#pragma unroll
          for (int tl = 0; tl < 2; ++tl) {
              const int it = (wid & 1) ? tl : tl, tt = (wid & 1) ? 1 - tl : tl;
              f32x4 acc = {0.f, 0.f, 0.f, 0.f};
              if (!((wid & 1) && tl == 1)) {
#pragma unroll
                  for (int ks = 0; ks < 2; ++ks) acc = __builtin_amdgcn_mfma_f32_16x16x32_bf16(ldfrag(X, it * 16 + L15, 72, ks * 32 + QD * 8), ldfrag(Yt, tt * 16 + L15, 72, ks * 32 + QD * 8), acc, 0, 0, 0);
              }
              const int t = tt * 16 + L15, i0 = it * 16 + QD * 4;
              float o[4];
#pragma unroll
              for (int j = 0; j < 4; ++j) { const int i = i0 + j; const bool keep = strict ? (i < t) : (i <= t); o[j] = keep ? acc[j] * sgn : 0.f; }
              if (am == 1) { const int tp = (t & 15) * 2 + (t >> 4); A2f[(i0 + 0) * 32 + tp] = o[0]; A2f[(i0 + 1) * 32 + tp] = o[1]; A2f[(i0 + 2) * 32 + tp] = o[2]; A2f[(i0 + 3) * 32 + tp] = o[3]; }
              else store_bf4(AT + t * 40 + i0, o[0], o[1], o[2], o[3]);
          } }
        { const int which = wid >> 2, mt = wid & 3; const bf16_t* Yt = KKt + which * 2304;
#pragma unroll
          for (int nt = 0; nt < 2; ++nt) { f32x4 acc = {0.f, 0.f, 0.f, 0.f};
#pragma unroll
              for (int ks = 0; ks < 2; ++ks) acc = __builtin_amdgcn_mfma_f32_16x16x32_bf16(ldfrag(S0b, mt * 16 + L15, 72, ks * 32 + QD * 8), ldfrag(Yt, nt * 16 + L15, 72, ks * 32 + QD * 8), acc, 0, 0, 0);
              P[nt] = acc; } }
        LBAR();
        if (wid < 4) { const int mt = wid;
#pragma unroll
            for (int nt = 0; nt < 2; ++nt) { P[nt] = __builtin_amdgcn_mfma_f32_16x16x32_bf16(ldfrag(VT, mt * 16 + L15, 40, QD * 8), ldfrag(A1T, nt * 16 + L15, 40, QD * 8), P[nt], 0, 0, 0);
#pragma unroll
                for (int j = 0; j < 4; ++j) RHSf[(mt * 16 + QD * 4 + j) * 36 + nt * 16 + L15] = P[nt][j]; } }
        else { const int mt = wid & 3;
#pragma unroll
            for (int nt = 0; nt < 2; ++nt) P[nt] = __builtin_amdgcn_mfma_f32_16x16x32_bf16(ldfrag(VT, mt * 16 + L15, 40, QD * 8), ldfrag(A1T + 1280, nt * 16 + L15, 40, QD * 8), P[nt], 0, 0, 0); }
        LBAR();
        {
            const int t16 = LN & 15, r4 = LN >> 4;
            const int rowA = wid * 8 + r4, rowB = rowA + 4;
            float aL = RHSf[rowA * 36 + t16], aH = RHSf[rowA * 36 + 16 + t16], bL = RHSf[rowB * 36 + t16], bH = RHSf[rowB * 36 + 16 + t16];
#define BC(x, i) __int_as_float(__builtin_amdgcn_update_dpp(0, __float_as_int(x), 0x150 + (i), 0xF, 0xF, true))
#define SOLVE1(i) { const f32x2_t cc = *(const f32x2_t*)(A2f + (i) * 32 + t16 * 2); const float c0 = cc.x, c1 = cc.y; const float ua = BC(aL, i), ub = BC(bL, i); \
                if ((i) < 15) { aL -= ua * c0; bL -= ub * c0; } aH -= ua * c1; bH -= ub * c1; }
#define SOLVE2(i) { const float c1 = A2f[(16 + (i)) * 32 + t16 * 2 + 1]; const float ua = BC(aH, i), ub = BC(bH, i); aH -= ua * c1; bH -= ub * c1; }
            SOLVE1(0) SOLVE1(1) SOLVE1(2) SOLVE1(3) SOLVE1(4) SOLVE1(5) SOLVE1(6) SOLVE1(7) SOLVE1(8) SOLVE1(9) SOLVE1(10) SOLVE1(11) SOLVE1(12) SOLVE1(13) SOLVE1(14) SOLVE1(15)
            SOLVE2(0) SOLVE2(1) SOLVE2(2) SOLVE2(3) SOLVE2(4) SOLVE2(5) SOLVE2(6) SOLVE2(7) SOLVE2(8) SOLVE2(9) SOLVE2(10) SOLVE2(11) SOLVE2(12) SOLVE2(13) SOLVE2(14)
#undef SOLVE1
#undef SOLVE2
#undef BC
            Ub[rowA * 40 + t16] = f2bf(aL); Ub[rowA * 40 + 16 + t16] = f2bf(aH); Ub[rowB * 40 + t16] = f2bf(bL); Ub[rowB * 40 + 16 + t16] = f2bf(bH); }
        LBAR();
        if (wid >= 4) { const int mt = wid & 3;
#pragma unroll
            for (int nt = 0; nt < 2; ++nt) {
                P[nt] = __builtin_amdgcn_mfma_f32_16x16x32_bf16(ldfrag(Ub, mt * 16 + L15, 40, QD * 8), ldfrag(A1T + 2560, nt * 16 + L15, 40, QD * 8), P[nt], 0, 0, 0);
                const int tok = SCAN_TOK(n * 32 + nt * 16 + L15);
                store_bf4(Y + ((size_t)z * M_TOK + tok) * 512 + h * 64 + mt * 16 + QD * 4, P[nt][0], P[nt][1], P[nt][2], P[nt][3]); } }
#pragma unroll
        for (int q = 0; q < 2; ++q) { const int kt = kt0 + q;
            S[q] = __builtin_amdgcn_mfma_f32_16x16x32_bf16(ldfrag(VT, vt * 16 + L15, 40, QD * 8), ldfrag(KDT, kt * 16 + L15, 40, QD * 8), S[q], 0, 0, 0);
            S[q] = __builtin_amdgcn_mfma_f32_16x16x32_bf16(ldfrag(Ub, vt * 16 + L15, 40, QD * 8), ldfrag(BBT, kt * 16 + L15, 40, QD * 8), S[q], 0, 0, 0);
            const float cl = CL[kt * 16 + L15];
#pragma unroll
            for (int j = 0; j < 4; ++j) { S[q][j] *= cl; S0b[(vt * 16 + QD * 4 + j) * 72 + kt * 16 + L15] = f2bf(S[q][j]); } }
    }
    LBAR();
    if (!latent) { float* so = p.out + OUT_STATE + ((size_t)((b * 2 + z) * 8 + h)) * 4096;
#pragma unroll
        for (int q = 0; q < 2; ++q)
#pragma unroll
            for (int j = 0; j < 4; ++j) so[(vt * 16 + quad * 4 + j) * 64 + (kt0 + q) * 16 + l15] = S[q][j]; }
    LBAR();
#undef SCAN_PREFETCH
#undef SCAN_TOK
}

DI void attn_unit(const Params& p, unsigned char* ldsg, bool latent, int b, int h, int qb, float lam) {
    int tid = threadIdx.x; asm volatile("" : "+v"(tid));
    const int lane = tid & 63, wid = __builtin_amdgcn_readfirstlane(tid >> 6), r = lane & 31, hh = lane >> 5, qg = wid & 3, mp = wid >> 2;
    const int Tk = latent ? 4352 : 256, NT = Tk >> 6;
    const size_t qrow0 = (size_t)(latent ? M_CTX + b * 4096 : b * 256) + qb * 128;
    const bf16_t* Qb = (const bf16_t*)(p.ws + OFF_QB);
    const bf16_t* Kg = (latent ? (const bf16_t*)(p.ws + OFF_KL) + (size_t)b * 4352 * 512 : (const bf16_t*)(p.ws + OFF_KC) + (size_t)b * 256 * 512) + h * 128;
    const bf16_t* Vg = latent ? (const bf16_t*)(p.ws + OFF_VTL) + (size_t)(b * 4 + h) * 128 * 4352 : (const bf16_t*)(p.ws + OFF_VTC) + (size_t)(b * 4 + h) * 128 * 256;
    bf16x8 qf[4];
#pragma unroll
    for (int kk = 0; kk < 4; ++kk) qf[kk] = *(const bf16x8*)(Qb + (qrow0 + 32 * qg + r) * 512 + h * 128 + mp * 64 + 16 * kk + 8 * hh);
    const int krow = tid >> 3, kch = tid & 7, vrow = tid >> 2, vch = tid & 3;
    const bf16_t* kgp = Kg + (size_t)krow * 512 + kch * 8;
    const bf16_t* vgp = Vg + (size_t)vrow * Tk + vch * 8;
    unsigned char* kl = ldsg + krow * 272 + kch * 16;
    unsigned char* vl = ldsg + 34816 + vrow * 144 + (vch >> 1) * 32 + (vch & 1) * 8;
    u32x4 kr0, kr1, vr0, vr1;
#define ATT_LOAD(j) do { kr0 = *(const u32x4*)(kgp + (size_t)(j) * 64 * 512); kr1 = *(const u32x4*)(kgp + (size_t)(j) * 64 * 512 + 64); vr0 = *(const u32x4*)(vgp + (size_t)(j) * 64); vr1 = *(const u32x4*)(vgp + (size_t)(j) * 64 + 32); } while (0)
#define ATT_STORE(bf) do { *(u32x4*)(kl + (bf) * 17408) = kr0; *(u32x4*)(kl + (bf) * 17408 + 128) = kr1; \
        *(u32x2*)(vl + (bf) * 18432) = (u32x2){vr0.x, vr0.y}; *(u32x2*)(vl + (bf) * 18432 + 16) = (u32x2){vr0.z, vr0.w}; \
        *(u32x2*)(vl + (bf) * 18432 + 64) = (u32x2){vr1.x, vr1.y}; *(u32x2*)(vl + (bf) * 18432 + 80) = (u32x2){vr1.z, vr1.w}; } while (0)
    ATT_LOAD(0);
    f32x16 o[4];
#pragma unroll
    for (int d = 0; d < 4; ++d)
#pragma unroll
        for (int i = 0; i < 16; ++i) o[d][i] = 0.f;
    float lsum = 0.f;
    const float CS = 0.125f * LOG2E;
    float mref;
    { float qs = 0.f;
#pragma unroll
      for (int kk = 0; kk < 4; ++kk)
#pragma unroll
          for (int j = 0; j < 8; ++j) { const float x = bf2f((unsigned short)qf[kk][j]); qs += x * x; }
      qs += __shfl_xor(qs, 32);
      const float kmax2 = __uint_as_float(((const unsigned*)(p.ws + OFF_KMAX))[(latent ? b * 8 : 64 + b * 8) + h * 2 + mp]);
      mref = sqrtf(qs * kmax2) * CS; }
    ATT_STORE(0);
    LBAR();
    for (int j = 0; j < NT; ++j) {
        const int bf = j & 1;
        if (j + 1 < NT) ATT_LOAD(j + 1);
        const unsigned char* kb = ldsg + bf * 17408 + r * 272 + (mp * 64 + 8 * hh) * 2;
        const unsigned char* vb = ldsg + 34816 + bf * 18432 + r * 144 + 16 * hh;
        f32x16 st[2];
#pragma unroll
        for (int kt = 0; kt < 2; ++kt) {
#pragma unroll
            for (int i = 0; i < 16; ++i) st[kt][i] = 0.f;
#pragma unroll
            for (int kk = 0; kk < 4; ++kk) { const bf16x8 kf = *(const bf16x8*)(kb + kt * 32 * 272 + kk * 32); st[kt] = __builtin_amdgcn_mfma_f32_32x32x16_bf16(kf, qf[kk], st[kt], 0, 0, 0); }
        }
        float ps = 0.f;
#pragma unroll
        for (int kt = 0; kt < 2; ++kt)
#pragma unroll
            for (int i = 0; i < 16; ++i) { const float e = __builtin_amdgcn_exp2f(st[kt][i] * CS - mref); st[kt][i] = e; ps += e; }
        lsum += ps;
#pragma unroll
        for (int kt = 0; kt < 2; ++kt)
#pragma unroll
            for (int s = 0; s < 2; ++s) {
                u32x4 pw; pw.x = cvtpk(st[kt][8 * s], st[kt][8 * s + 1]); pw.y = cvtpk(st[kt][8 * s + 2], st[kt][8 * s + 3]); pw.z = cvtpk(st[kt][8 * s + 4], st[kt][8 * s + 5]); pw.w = cvtpk(st[kt][8 * s + 6], st[kt][8 * s + 7]);
                const bf16x8 pf = __builtin_bit_cast(bf16x8, pw);
#pragma unroll
                for (int d = 0; d < 4; ++d) {
                    const u32x4 vw = *(const u32x4*)(vb + d * 32 * 144 + (kt * 32 + 16 * s) * 2);
                    o[d] = __builtin_amdgcn_mfma_f32_32x32x16_bf16(__builtin_bit_cast(bf16x8, vw), pf, o[d], 0, 0, 0);
                }
            }
        if (j + 1 < NT) ATT_STORE(bf ^ 1);
        LBAR();
    }
#undef ATT_LOAD
#undef ATT_STORE
    const float ltot = lsum + __shfl_xor(lsum, 32);
    const float il = 1.0f / ltot;
    float* X = (float*)ldsg + qg * 4096;
    if (mp == 1) {
#pragma unroll
        for (int d = 0; d < 4; ++d)
#pragma unroll
            for (int g = 0; g < 4; ++g) *(f32x4*)(X + ((d * 4 + g) * 64 + lane) * 4) = (f32x4){o[d][4 * g] * il, o[d][4 * g + 1] * il, o[d][4 * g + 2] * il, o[d][4 * g + 3] * il};
    }
    LBAR();
    if (mp == 0) {
        float ss = 0.f;
#pragma unroll
        for (int d = 0; d < 4; ++d)
#pragma unroll
            for (int g = 0; g < 4; ++g) { const f32x4 xv = *(const f32x4*)(X + ((d * 4 + g) * 64 + lane) * 4);
#pragma unroll
                for (int e = 0; e < 4; ++e) { const float c = o[d][4 * g + e] * il - lam * xv[e]; o[d][4 * g + e] = c; ss += c * c; } }
        ss += __shfl_xor(ss, 32);
        const float rs = rsqrtf(ss * (1.0f / 128.0f) + 1e-6f) * 0.8f;
        const float* sw = p.in[18];
        bf16_t* OA = (bf16_t*)((unsigned char*)p.out + (size_t)M_TOK * 2048) + (qrow0 + 32 * qg + r) * 1024 + h * 128;
#pragma unroll
        for (int d = 0; d < 4; ++d)
#pragma unroll
            for (int g = 0; g < 4; ++g) { const int dd = d * 32 + 8 * g + 4 * hh; const f32x4 w = *(const f32x4*)(sw + dd);
                store_bf4(OA + dd, o[d][4 * g] * rs * w[0], o[d][4 * g + 1] * rs * w[1], o[d][4 * g + 2] * rs * w[2], o[d][4 * g + 3] * rs * w[3]); }
    }
    LBAR();
}

DI void phase_post(const Params& p) {
    const int tid = threadIdx.x, lane = tid & 63, wid = __builtin_amdgcn_readfirstlane(tid >> 6);
    const bf16_t* Y = (const bf16_t*)(p.ws + OFF_H1); const float* BS = (const float*)(p.ws + OFF_BS);
    const bf16_t* Vr = (const bf16_t*)(p.ws + OFF_VR); const bf16_t* Gr = (const bf16_t*)(p.ws + OFF_GR); bf16_t* OR = (bf16_t*)((unsigned char*)p.out + (size_t)M_TOK * 2048) + 512;
    const int c0 = lane * 8, h = lane >> 3;
    f32x4 lw[2], lb[2];
#pragma unroll
    for (int j = 0; j < 2; ++j) { lw[j] = *(const f32x4*)(p.in[26] + c0 + 4 * j); lb[j] = *(const f32x4*)(p.in[27] + c0 + 4 * j); }
    for (int row = blockIdx.x * 8 + wid; row < M_TOK; row += gridDim.x * 8) {
        f32x4 y[2];
        { const u32x4 ya = *(const u32x4*)(Y + (size_t)row * 512 + c0), yb = *(const u32x4*)(Y + ((size_t)M_TOK + row) * 512 + c0);
#pragma unroll
          for (int j = 0; j < 2; ++j)
#pragma unroll
              for (int e2 = 0; e2 < 2; ++e2) { const unsigned wa = ya[2 * j + e2], wb = yb[2 * j + e2];
                  y[j][2 * e2] = __uint_as_float(wa << 16) + __uint_as_float(wb << 16); y[j][2 * e2 + 1] = __uint_as_float(wa & 0xffff0000u) + __uint_as_float(wb & 0xffff0000u); } }
        float s = (y[0][0] + y[0][1]) + (y[0][2] + y[0][3]) + (y[1][0] + y[1][1]) + (y[1][2] + y[1][3]);
        s += __shfl_xor(s, 1); s += __shfl_xor(s, 2); s += __shfl_xor(s, 4);
        const float mu = s * (1.0f / 64.0f);
        float q = 0.f;
#pragma unroll
        for (int j = 0; j < 2; ++j)
#pragma unroll
            for (int e = 0; e < 4; ++e) { const float d = y[j][e] - mu; q += d * d; }
        q += __shfl_xor(q, 1); q += __shfl_xor(q, 2); q += __shfl_xor(q, 4);
        const float rstd = rsqrtf(q * (1.0f / 64.0f) + 64e-5f);
        const float bon = BS[(size_t)row * 8 + h] + BS[((size_t)M_TOK + row) * 8 + h];
        const u32x4 vv = *(const u32x4*)(Vr + (size_t)row * 512 + c0); const u32x2 gg = *(const u32x2*)((const unsigned char*)Gr + (size_t)row * 512 + c0);
        float ov[8];
#pragma unroll
        for (int j = 0; j < 2; ++j)
#pragma unroll
            for (int e = 0; e < 4; ++e) { const int i = 4 * j + e; const unsigned vw = vv[i >> 1];
                const float v = (i & 1) ? __uint_as_float(vw & 0xffff0000u) : __uint_as_float(vw << 16);
                const float sg = (float)(((j ? gg.y : gg.x) >> (8 * e)) & 255u) * (1.0f / 255.0f);
                const float yn = (y[j][e] - mu) * rstd * lw[j][e] + lb[j][e];
                ov[i] = (yn + bon * v) * sg; }
        u32x4 w; w.x = cvtpk(ov[0], ov[1]); w.y = cvtpk(ov[2], ov[3]); w.z = cvtpk(ov[4], ov[5]); w.w = cvtpk(ov[6], ov[7]);
        *(u32x4*)(OR + (size_t)row * 1024 + c0) = w;
    }
}
template <class Epi> DI void run_gemm(unsigned char* lds, const bf16_t* A, const bf16_t* Bt, int N, int K, const Epi& E) {
    pg8::Gemm g; g.A = A; g.Bt = Bt; g.M = M_TOK; g.N = N; g.K = K;
    pg8::StaticOrder S; S.init(M_TOK, N, (int)gridDim.x, (int)blockIdx.x);
    pg8::gemm_phase<Epi, pg8::StaticOrder, true, true>((PG8_LAS unsigned char*)lds, g, S, E);
}

__global__ void __launch_bounds__(512, 2) fwd_megakernel(Params p) {
    extern __shared__ __attribute__((aligned(16))) unsigned char lds[];
    cg::grid_group grid = cg::this_grid();
    const int tid = threadIdx.x;
    volatile XLAS unsigned* xst = (volatile XLAS unsigned*)(lds + 131072 + 16);
    if (tid < 2) xst[tid] = 0u;
    __syncthreads();
    unsigned char* ws = p.ws;
    float* MOD = (float*)(ws + OFF_MOD);
    bf16_t* H1 = (bf16_t*)(ws + OFF_H1);
    phase_prep(p, lds);
    grid.sync();
    const XcdBarrier xb = xcd_barrier_post((unsigned*)(p.ws + OFF_XBAR), xst);
    phase_cachek(p);
    phase_norm<false>(p.in[0], p.in[1], nullptr, p.in[9], MOD, 0, 1, H1);
    xcd_barrier(xb);
    { Epi1 E; E.ws = ws; E.out = p.out;
      run_gemm(lds, H1, (const bf16_t*)(ws + OFF_WINT), 5888, 1024, E); }
    xcd_barrier(xb);
    { float lam;
      { const int lane = tid & 63; float a = p.in[14][lane] * p.in[15][lane], b2 = p.in[16][lane] * p.in[17][lane];
#pragma unroll
        for (int o = 32; o >= 1; o >>= 1) { a += __shfl_xor(a, o); b2 += __shfl_xor(b2, o); }
        lam = __expf(a) - __expf(b2) + 0.2f; }
      unsigned* ctr = (unsigned*)(ws + OFF_CTL);
      volatile int* wq = (volatile int*)(lds + 131072);
      int it = (int)blockIdx.x;
      for (;;) {
          if (it >= 1920) break;
          int nxt_it = 0;
          if (tid == 0) nxt_it = (int)atomicAdd(ctr, 1u) + (int)gridDim.x;
          bool is_scan, lat; int a0, a1, a2;
          if (it < 128) { is_scan = true; lat = true; a0 = it >> 4; a1 = (it >> 3) & 1; a2 = it & 7; }
          else if (it < 1152) { const int u = it - 128; is_scan = false; lat = true; a0 = u >> 7; a1 = (u >> 5) & 3; a2 = u & 31; }
          else if (it < 1664) { const int u = it - 1152; is_scan = true; lat = false; a0 = u >> 4; a1 = (u >> 3) & 1; a2 = u & 7; }
          else { const int u = it - 1664; is_scan = false; lat = false; a0 = u >> 3; a1 = (u >> 1) & 3; a2 = u & 1; }
          if (is_scan) scan_chain(p, lds, lat, a0, a1, a2); else attn_unit(p, lds, lat, a0, a1, a2, lam);
          if (tid == 0) *wq = nxt_it;
          LBAR();
          it = *wq;
          LBAR();
      } }
    xcd_barrier(xb);
    phase_post(p);
    xcd_barrier(xb);
    { EpiMerge1 E; E.G = (const unsigned char*)p.out; E.MG = (bf16_t*)(ws + OFF_MERGED);
      run_gemm(lds, (const bf16_t*)((unsigned char*)p.out + (size_t)M_TOK * 2048), (const bf16_t*)(ws + OFF_WAT), 1024, 1024, E); }
    xcd_barrier(xb);
    { EpiResid<0> E; E.xa = p.in[0]; E.xb = p.in[1]; E.out = p.out + OUT_Y; E.MOD = MOD; E.gidx = 2; E.X1b = (bf16_t*)(ws + OFF_X1B);
      run_gemm(lds, (const bf16_t*)(ws + OFF_MERGED), (const bf16_t*)(ws + OFF_WOT), 1024, 1024, E); }
    xcd_barrier(xb);
    phase_norm<true>(nullptr, nullptr, (const bf16_t*)(ws + OFF_X1B), p.in[10], MOD, 3, 4, H1);
    xcd_barrier(xb);
    { EpiSwiGLU E; E.ACT = (bf16_t*)(ws + OFF_ACT); run_gemm(lds, H1, (const bf16_t*)(ws + OFF_WFIT), 5632, 1024, E); }
    xcd_barrier(xb);
    { EpiResid<1> E; E.xa = nullptr; E.xb = nullptr; E.out = p.out + OUT_Y; E.MOD = MOD; E.gidx = 5; E.X1b = (bf16_t*)(ws + OFF_X1B);
      run_gemm(lds, (const bf16_t*)(ws + OFF_ACT), (const bf16_t*)(ws + OFF_WFOT), 1024, 2816, E); }
}

extern "C" void kernel_launch(void* const* d_in, const int* in_sizes, int n_in, void* d_out, int out_size, void* d_ws, size_t ws_size, hipStream_t stream) {
    static int grid_blocks = 0;
    if (grid_blocks == 0) {
        if (n_in != 33 || ws_size < WS_END) { fprintf(stderr, "kernel_launch: need 33 inputs and >= %zu bytes of workspace; got %d inputs, %zu bytes\n", (size_t)WS_END, n_in, ws_size); grid_blocks = -1; return; }
        int dev = 0, cus = 0, per_cu = 0;
        hipGetDevice(&dev);
        hipDeviceGetAttribute(&cus, hipDeviceAttributeMultiprocessorCount, dev);
        if (hipFuncSetAttribute((const void*)fwd_megakernel, hipFuncAttributeMaxDynamicSharedMemorySize, LDS_BYTES) != hipSuccess) fprintf(stderr, "kernel_launch: hipFuncSetAttribute failed\n");
        if (hipOccupancyMaxActiveBlocksPerMultiprocessor(&per_cu, (const void*)fwd_megakernel, 512, LDS_BYTES) != hipSuccess || per_cu < 1) { fprintf(stderr, "kernel_launch: occupancy query gives %d\n", per_cu); per_cu = 1; }
        (void)hipGetLastError();
        grid_blocks = cus;
        if (grid_blocks > cus * per_cu) grid_blocks = cus * per_cu;
    }
    if (grid_blocks < 0) return;
    Params p{};
    for (int i = 0; i < 33; ++i) p.in[i] = (const float*)d_in[i];
    p.out = (float*)d_out; p.ws = (unsigned char*)d_ws; p.ws_size = 0ull;
    void* args[] = {&p};
    hipError_t e = hipLaunchCooperativeKernel((const void*)fwd_megakernel, dim3(grid_blocks), dim3(512), args, LDS_BYTES, stream);
    if (e != hipSuccess) fprintf(stderr, "cooperative launch failed: %s (grid %d)\n", hipGetErrorString(e), grid_blocks);
}
```

```cpp
#include <hip/hip_runtime.h>
#include <hip/hip_cooperative_groups.h>
#include <cstdio>
#include <cstdint>
namespace cg = cooperative_groups;
namespace pg8 {
#define PG8_LAS __attribute__((address_space(3)))
typedef unsigned short bf16_t;
typedef short bf16x8 __attribute__((ext_vector_type(8)));
typedef float f32x4 __attribute__((ext_vector_type(4)));
typedef unsigned u32x4 __attribute__((ext_vector_type(4)));
constexpr int BM = 256, BK = 64, HALF = 128, HTB = HALF * BK * 2  , STAGE_BYTES = 8 * HTB, NXCD = 8, WGM = 8;

__host__ __device__ __forceinline__ int lds_byte(int r, int c) { const int st = (r >> 4) * 2 + (c >> 5), rr = r & 15, cc = c & 31, ob = rr * 64 + cc * 2; return st * 1024 + (ob ^ (((ob >> 9) & 1) << 5)); }
__host__ __device__ __forceinline__ void stage_rc(int b, int& R, int& C) { const int st = b / 1024, sb = b % 1024, swz = sb ^ (((sb >> 9) & 1) << 5); R = (st >> 1) * 16 + swz / 64; C = (st & 1) * 32 + (swz % 64) / 2; }
__host__ __device__ __forceinline__ int perm32(int rho) { const int n = rho >> 4, i = rho & 15; return 8 * (i >> 2) + 4 * n + (i & 3); }

struct Unit { int pm, pn; };
struct Gemm { const bf16_t* A; const bf16_t* Bt; int M, N, K; };

struct StaticOrder {
    int nM, nN, nwg, G, c;
    __host__ __device__ void init(int M, int N, int G_, int c_) { nM = M / BM; nN = N / BM; nwg = nM * nN; G = G_; c = c_; }
    __host__ __device__ bool next(int i, Unit& u) const {
        const long L = (long)i * G + c; if (L >= nwg) return false;
        int wgid = (int)L; { const int q = nwg / NXCD, r = nwg % NXCD, xcd = wgid % NXCD, off = wgid / NXCD; wgid = (xcd < r ? xcd * (q + 1) : r * (q + 1) + (xcd - r) * q) + off; }
        const int nig = WGM * nN, gid = wgid / nig, fm = gid * WGM, gsz = (nM - fm) < WGM ? (nM - fm) : WGM;
        u.pm = fm + ((wgid % nig) % gsz); u.pn = (wgid % nig) / gsz; return true;
    }
    __device__ __forceinline__ void a_ready(const Unit&) const {}
    __device__ __forceinline__ void done(const Unit&) const {}
};
__device__ __forceinline__ unsigned cvt_pk_bf16(float lo, float hi) { unsigned r; asm volatile("v_cvt_pk_bf16_f32 %0, %1, %2" : "=v"(r) : "v"(lo), "v"(hi)); return r; }
typedef float f32x2 __attribute__((ext_vector_type(2)));
template <class Epi, class Sched, bool ALIGN_EPI = false, bool SP2 = false>
__device__ __forceinline__ void gemm_phase(PG8_LAS unsigned char* lds, const Gemm g, const Sched& S, const Epi& E) {
    const int tid = threadIdx.x, wid = __builtin_amdgcn_readfirstlane(tid >> 6), lane = tid & 63, wr = wid >> 2, wc = wid & 3, fr = lane & 15, fq = lane >> 4;
    const int K = g.K, nt = K / BK;
    unsigned voffA[2], voffB[2];
#pragma unroll
    for (int i = 0; i < 2; ++i) { int R, C; stage_rc(tid * 16 + i * 8192, R, C); const int Rb = Epi::PERM ? ((R & ~31) + perm32(R & 31)) : R;
        voffA[i] = (unsigned)(R * K + C) * 2u; voffB[i] = (unsigned)(Rb * K + C) * 2u; }
    const size_t kstep = (size_t)(BK * 2);
    const size_t hstep = (size_t)HALF * K * 2;
    const size_t tstep = 2 * hstep;
    const unsigned ldsw = (unsigned)wid * 1024u;
    const int aoff = lds_byte(wr * 64 + fr, fq * 8), boff = lds_byte(wc * 32 + fr, fq * 8);
#define PG8_SA(b, h) (((b) * 2 + (h)) * HTB)
#define PG8_SB(b, h) ((4 + (b) * 2 + (h)) * HTB)
#define PG8_STAGE(bufoff, gbase, voff) do { _Pragma("unroll") for (int _i = 0; _i < 2; ++_i) \
        __builtin_amdgcn_global_load_lds((const unsigned*)((const char*)(gbase) + (voff)[_i]), (PG8_LAS unsigned*)(lds + (bufoff) + ldsw + _i * 8192), 16, 0, 0); } while (0)
#define PG8_LDA(dst, b, h) do { _Pragma("unroll") for (int m = 0; m < 4; ++m) _Pragma("unroll") for (int k = 0; k < 2; ++k) dst[m][k] = *(const PG8_LAS bf16x8*)(lds + PG8_SA(b, h) + aoff + m * 2048 + k * 1024); } while (0)
#define PG8_LDB(dst, b, h) do { _Pragma("unroll") for (int n = 0; n < 2; ++n) _Pragma("unroll") for (int k = 0; k < 2; ++k) dst[n][k] = *(const PG8_LAS bf16x8*)(lds + PG8_SB(b, h) + boff + n * 2048 + k * 1024); } while (0)
#define PG8_MMA(ai, bj, At, Bt) do { __builtin_amdgcn_s_setprio(1); _Pragma("unroll") for (int m = 0; m < 4; ++m) _Pragma("unroll") for (int n = 0; n < 2; ++n) _Pragma("unroll") for (int k = 0; k < 2; ++k) \
        acc[ai][bj][m][n] = __builtin_amdgcn_mfma_f32_16x16x32_bf16(Bt[n][k], At[m][k], acc[ai][bj][m][n], 0, 0, 0); __builtin_amdgcn_s_setprio(0); } while (0)
#define PG8_WAIT_V(n) asm volatile("s_waitcnt vmcnt(" #n ")" ::: "memory")
#define PG8_WAIT_L(n) asm volatile("s_waitcnt lgkmcnt(" #n ")" ::: "memory")
#define PG8_BAR __builtin_amdgcn_s_barrier()
#define PG8_SCHED __builtin_amdgcn_sched_barrier(0)
    Unit cur, nxt; int ui = 0;
    if (!S.next(0, cur)) return;
    f32x4 acc[2][2][4][2];
#pragma unroll
    for (int a = 0; a < 2; ++a)
#pragma unroll
        for (int b = 0; b < 2; ++b)
#pragma unroll
            for (int m = 0; m < 4; ++m)
#pragma unroll
                for (int n = 0; n < 2; ++n) acc[a][b][m][n] = (f32x4){0.f, 0.f, 0.f, 0.f};
    bf16x8 At[4][2], B0[2][2], B1[2][2];
    const char* cA = (const char*)g.A + (size_t)cur.pm * tstep; const char* cB = (const char*)g.Bt + (size_t)cur.pn * tstep;
    S.a_ready(cur);
    if constexpr (SP2) {
        PG8_STAGE(PG8_SB(0, 0), cB, voffB); PG8_STAGE(PG8_SB(0, 1), cB + hstep, voffB); PG8_STAGE(PG8_SA(0, 0), cA, voffA); PG8_STAGE(PG8_SA(0, 1), cA + hstep, voffA);
        if (wr == 1) PG8_BAR;
        PG8_WAIT_V(2); PG8_BAR;
        PG8_STAGE(PG8_SB(1, 0), cB + kstep, voffB); PG8_STAGE(PG8_SA(1, 0), cA + kstep, voffA); PG8_STAGE(PG8_SB(1, 1), cB + hstep + kstep, voffB);
        PG8_WAIT_V(6); PG8_BAR;
    } else {
        PG8_STAGE(PG8_SB(0, 0), cB, voffB); PG8_STAGE(PG8_SA(0, 0), cA, voffA); PG8_STAGE(PG8_SB(0, 1), cB + hstep, voffB); PG8_STAGE(PG8_SA(0, 1), cA + hstep, voffA);
        if (wr == 1) PG8_BAR;
        PG8_WAIT_V(4); PG8_BAR;
        PG8_STAGE(PG8_SB(1, 0), cB + kstep, voffB); PG8_STAGE(PG8_SA(1, 0), cA + kstep, voffA); PG8_STAGE(PG8_SB(1, 1), cB + hstep + kstep, voffB);
        PG8_WAIT_V(6); PG8_BAR;
    }
    for (;;) {
        const bool has_next = S.next(ui + 1, nxt);
        const char* nA = has_next ? (const char*)g.A + (size_t)nxt.pm * tstep : cA; const char* nB = has_next ? (const char*)g.Bt + (size_t)nxt.pn * tstep : cB;
        for (int t = 0; t < nt; t += 2) {
            if constexpr (Epi::MIDK) { if (t == nt / 2) E.mid(acc, cur, wr, wc, fr, fq); }
            const bool last = (t == nt - 2);
            const char* a1 = cA + (size_t)(t + 1) * kstep;
            const char* a2 = last ? nA : cA + (size_t)(t + 2) * kstep; const char* b2 = last ? nB : cB + (size_t)(t + 2) * kstep;
            const char* a3 = a2 + kstep; const char* b3 = b2 + kstep;
            if (last && has_next) S.a_ready(nxt);
            if constexpr (SP2) {
            PG8_LDB(B0, 0, 0); PG8_LDB(B1, 0, 1); PG8_SCHED; PG8_LDA(At, 0, 0); PG8_STAGE(PG8_SA(1, 1), a1 + hstep, voffA);
            PG8_WAIT_V(8); PG8_WAIT_L(0); PG8_BAR; PG8_MMA(0, 0, At, B0); PG8_MMA(0, 1, At, B1); PG8_BAR; PG8_SCHED;
            PG8_LDA(At, 0, 1); PG8_STAGE(PG8_SB(0, 0), b2, voffB); PG8_STAGE(PG8_SB(0, 1), b2 + hstep, voffB); PG8_STAGE(PG8_SA(0, 0), a2, voffA);
            PG8_WAIT_V(8); PG8_WAIT_L(0); PG8_BAR; PG8_MMA(1, 0, At, B0); PG8_MMA(1, 1, At, B1); PG8_BAR; PG8_SCHED;
            PG8_LDB(B0, 1, 0); PG8_LDB(B1, 1, 1); PG8_SCHED; PG8_LDA(At, 1, 0); PG8_STAGE(PG8_SA(0, 1), a2 + hstep, voffA);
            PG8_WAIT_V(8); PG8_WAIT_L(0); PG8_BAR; PG8_MMA(0, 0, At, B0); PG8_MMA(0, 1, At, B1); PG8_BAR; PG8_SCHED;
            PG8_LDA(At, 1, 1); PG8_STAGE(PG8_SB(1, 0), b3, voffB); PG8_STAGE(PG8_SB(1, 1), b3 + hstep, voffB); PG8_STAGE(PG8_SA(1, 0), a3, voffA);
            PG8_WAIT_V(8); PG8_WAIT_L(0); PG8_BAR; PG8_MMA(1, 0, At, B0); PG8_MMA(1, 1, At, B1); PG8_BAR; PG8_SCHED;
            } else {
            PG8_LDB(B0, 0, 0); PG8_SCHED; PG8_LDA(At, 0, 0); PG8_STAGE(PG8_SA(1, 1), a1 + hstep, voffA);
            PG8_WAIT_L(8); PG8_BAR; PG8_WAIT_L(0); PG8_MMA(0, 0, At, B0); PG8_BAR; PG8_SCHED;
            PG8_LDB(B1, 0, 1); PG8_STAGE(PG8_SB(0, 0), b2, voffB);
            PG8_BAR; PG8_WAIT_L(0); PG8_MMA(0, 1, At, B1); PG8_BAR;
            PG8_LDA(At, 0, 1); PG8_STAGE(PG8_SA(0, 0), a2, voffA);
            PG8_BAR; PG8_WAIT_L(0); PG8_MMA(1, 0, At, B0); PG8_BAR; PG8_SCHED;
            PG8_STAGE(PG8_SB(0, 1), b2 + hstep, voffB);
            PG8_WAIT_V(6); PG8_BAR; PG8_MMA(1, 1, At, B1); PG8_BAR;
            PG8_LDB(B0, 1, 0); PG8_SCHED; PG8_LDA(At, 1, 0); PG8_STAGE(PG8_SA(0, 1), a2 + hstep, voffA);
            PG8_WAIT_L(8); PG8_BAR; PG8_WAIT_L(0); PG8_MMA(0, 0, At, B0); PG8_BAR; PG8_SCHED;
            PG8_LDB(B1, 1, 1); PG8_STAGE(PG8_SB(1, 0), b3, voffB);
            PG8_BAR; PG8_WAIT_L(0); PG8_MMA(0, 1, At, B1); PG8_BAR;
            PG8_LDA(At, 1, 1); PG8_STAGE(PG8_SA(1, 0), a3, voffA);
            PG8_BAR; PG8_WAIT_L(0); PG8_MMA(1, 0, At, B0); PG8_BAR; PG8_SCHED;
            PG8_STAGE(PG8_SB(1, 1), b3 + hstep, voffB);
            PG8_WAIT_V(6); PG8_BAR; PG8_MMA(1, 1, At, B1); PG8_BAR;
            }
        }
        if constexpr (ALIGN_EPI) { if (wr == 0) PG8_BAR; }
        if constexpr (!Epi::AFTER_DRAIN) { E(acc, cur, wr, wc, fr, fq); S.done(cur); }
        if (!has_next) break;
#pragma unroll
        for (int a = 0; a < 2; ++a)
#pragma unroll
            for (int b = 0; b < 2; ++b)
#pragma unroll
                for (int m = 0; m < 4; ++m)
#pragma unroll
                    for (int n = 0; n < 2; ++n) acc[a][b][m][n] = (f32x4){0.f, 0.f, 0.f, 0.f};
        cur = nxt; cA = nA; cB = nB; ++ui;
        if constexpr (ALIGN_EPI) { if (wr == 1) PG8_BAR; }
    }
    PG8_WAIT_V(0);
    if constexpr (!ALIGN_EPI) { if (wr == 0) PG8_BAR; }
    PG8_BAR;
    if constexpr (Epi::AFTER_DRAIN) { E.fused(acc, cur, wr, wc, fr, fq, lds, wid, lane); S.done(cur); }
#undef PG8_SA
#undef PG8_SB
#undef PG8_STAGE
#undef PG8_LDA
#undef PG8_LDB
#undef PG8_MMA
#undef PG8_WAIT_V
#undef PG8_WAIT_L
#undef PG8_BAR
#undef PG8_SCHED
}
}
using pg8::bf16_t; using pg8::f32x4; using pg8::Unit;
typedef short bf16x8 __attribute__((ext_vector_type(8)));
typedef float f32x16 __attribute__((ext_vector_type(16)));
typedef float f32x2_t __attribute__((ext_vector_type(2)));
typedef __bf16 bf16x2_t __attribute__((ext_vector_type(2)));
typedef unsigned u32x2 __attribute__((ext_vector_type(2)));
typedef unsigned u32x4 __attribute__((ext_vector_type(4)));
#define DI __device__ __forceinline__

constexpr int M_TOK = 40960, M_CTX = 8192;
constexpr float LOG2E = 1.4426950408889634f;

constexpr size_t al256(size_t x) { return (x + 255) & ~(size_t)255; }
constexpr size_t OFF_CTL = 0;
constexpr size_t OFF_KMAX = 2048;
constexpr size_t OFF_MOD = 4096;
constexpr size_t OFF_QKW = 1024;
constexpr size_t OFF_WINT = al256(OFF_MOD + 9 * 6144 * 4);
constexpr size_t OFF_WAT = OFF_WINT + (size_t)5888 * 1024 * 2;
constexpr size_t OFF_WRT = OFF_WAT + (size_t)1024 * 512 * 2;
constexpr size_t OFF_WOT = OFF_WRT + (size_t)1024 * 512 * 2;
constexpr size_t OFF_WFIT = OFF_WOT + (size_t)1024 * 1024 * 2;
constexpr size_t OFF_WFOT = OFF_WFIT + (size_t)5632 * 1024 * 2;
constexpr size_t OFF_WUPT = OFF_WFOT + (size_t)1024 * 2816 * 2;
constexpr size_t OFF_BS = OFF_WUPT + (size_t)4 * 512 * 64 * 2;
constexpr size_t OFF_H1 = al256(OFF_BS + (size_t)2 * M_TOK * 8 * 4);
constexpr size_t OFF_QB = OFF_H1 + (size_t)M_TOK * 1024 * 2;
constexpr size_t OFF_OA = OFF_QB + (size_t)M_TOK * 512 * 2;
constexpr size_t OFF_KC = OFF_OA + (size_t)M_TOK * 512 * 2;
constexpr size_t OFF_KL = OFF_KC + (size_t)32 * 256 * 512 * 2;
constexpr size_t OFF_VTC = OFF_KL + (size_t)8 * 4352 * 512 * 2;
constexpr size_t OFF_VTL = OFF_VTC + (size_t)32 * 4 * 128 * 256 * 2;
constexpr size_t OFF_R = OFF_VTL + (size_t)8 * 4 * 128 * 4352 * 2;
constexpr size_t OFF_KR = OFF_R + (size_t)M_TOK * 512 * 2;
constexpr size_t OFF_VR = OFF_KR + (size_t)M_TOK * 512 * 2;
constexpr size_t OFF_GR = OFF_VR + (size_t)M_TOK * 512 * 2;
constexpr size_t OFF_WLAL = OFF_GR + (size_t)M_TOK * 512 * 2;
constexpr size_t OFF_T2X = OFF_WLAL + (size_t)M_TOK * 256 * 2;
constexpr size_t OFF_XBAR = al256(OFF_T2X);
constexpr size_t WS_END = OFF_XBAR + 3456 * 4;
constexpr size_t OFF_OR = OFF_QB;
constexpr size_t OFF_T2 = OFF_R;
constexpr size_t OFF_MERGED = OFF_KC;
constexpr size_t OFF_ACT = OFF_QB;
constexpr size_t OFF_X1B = OFF_R + ((size_t)64 << 20);
static_assert(OFF_ACT + (size_t)M_TOK * 2816 * 2 <= OFF_X1B && OFF_X1B + (size_t)M_TOK * 1024 * 2 <= OFF_WLAL, "x1 placement");
static_assert(OFF_MERGED + (size_t)M_TOK * 1024 * 2 <= OFF_R, "merged overlay");
static_assert(OFF_ACT + (size_t)M_TOK * 2816 * 2 <= OFF_WLAL, "act overlay");
constexpr size_t OUT_Y = 0, OUT_NEWK = (size_t)M_TOK * 1024, OUT_NEWV = OUT_NEWK + (size_t)M_CTX * 512, OUT_STATE = OUT_NEWV + (size_t)M_CTX * 512;
constexpr int LDS_BYTES = 131072 + 256;

struct Params { const float* in[33]; float* out; unsigned char* ws; unsigned long long ws_size; };

DI float bf2f(unsigned short v) { return __uint_as_float(((unsigned)v) << 16); }
DI unsigned cvtpk(float lo, float hi) { f32x2_t v = {lo, hi}; bf16x2_t b = __builtin_convertvector(v, bf16x2_t); return __builtin_bit_cast(unsigned, b); }
DI unsigned short f2bf(float f) { return (unsigned short)(cvtpk(f, 0.f) & 0xffffu); }
DI float sigmoidf_(float x) { return __builtin_amdgcn_rcpf(1.0f + __builtin_amdgcn_exp2f(-x * LOG2E)); }
DI float tanhf_(float x) { return 1.0f - 2.0f * __builtin_amdgcn_rcpf(__builtin_amdgcn_exp2f(2.0f * LOG2E * x) + 1.0f); }
DI void store_bf4(bf16_t* p, float a, float b, float c, float d) { u32x2 w; w.x = cvtpk(a, b); w.y = cvtpk(c, d); *(u32x2*)p = w; }
DI void store_bf8(bf16_t* p, const f32x4 a, const f32x4 b) { u32x4 w; w.x = cvtpk(a[0], a[1]); w.y = cvtpk(a[2], a[3]); w.z = cvtpk(b[0], b[1]); w.w = cvtpk(b[2], b[3]); *(u32x4*)p = w; }
DI int cond_of_row(int row) { return row < M_CTX ? 8 : ((row - M_CTX) >> 12); }

DI int perm8(int p32) { return ((p32 >> 2) & 3) * 8 + (p32 >> 4) * 4 + (p32 & 3); }
DI int colmap(int mode, int n) {
    if (mode == 1) { if (n < 1024) { const int p = n & 255; return (n & ~255) + 64 * ((p >> 5) & 3) + 32 * (p >> 7) + (p & 31); }
                     if (n >= 1536) return (n & ~31) + perm8(n & 31);
                     return n; }
    if (mode == 2) { const int j = n >> 8, r = n & 255, q = (r & ~31) + perm8(r & 31); return (q < 128) ? 128 * j + q : 2816 + 128 * j + (q - 128); }
    if (mode == 3) return (n & ~31) + perm8(n & 31);
    return n;
}
DI void transpose_load(const float* src, int src_ld, int k0, int n0, int mode, float* tile) {
    const int tid = threadIdx.x, j = tid & 63, i0 = tid >> 6; const int sc = colmap(mode, n0 + j);
#pragma unroll
    for (int ps = 0; ps < 8; ++ps) { const int i = i0 + 8 * ps; tile[i * 65 + j] = src[(size_t)(k0 + i) * src_ld + sc]; }
}
DI void transpose_store(bf16_t* dst, int dst_ld, int k0, int n0, const float* tile) {
    const int tid = threadIdx.x, ii = tid & 63, j0 = tid >> 6;
#pragma unroll
    for (int ps = 0; ps < 8; ++ps) { const int jj = j0 + 8 * ps; dst[(size_t)(n0 + jj) * dst_ld + k0 + ii] = f2bf(tile[ii * 65 + jj]); }
}
struct TTask { const float* src; bf16_t* dst; int src_ld, dst_ld, k0, n0, mode; };
DI TTask transpose_task(const Params& p, int t) {
    TTask q; q.mode = 0;
    if (t < 1472) { q.src = p.in[11]; q.src_ld = 5888; q.dst = (bf16_t*)(p.ws + OFF_WINT); q.dst_ld = 1024; q.k0 = (t & 15) * 64; q.n0 = (t >> 4) * 64; q.mode = 1; }
    else if ((t -= 1472) < 128) { q.src = p.in[28]; q.src_ld = 1024; q.mode = 3; q.dst = (bf16_t*)(p.ws + OFF_WAT); q.dst_ld = 1024; q.k0 = (t & 7) * 64; q.n0 = (t >> 3) * 64; }
    else if ((t -= 128) < 128) { q.src = p.in[29]; q.src_ld = 1024; q.mode = 3; q.dst = (bf16_t*)(p.ws + OFF_WAT) + 512; q.dst_ld = 1024; q.k0 = (t & 7) * 64; q.n0 = (t >> 3) * 64; }
    else if ((t -= 128) < 256) { q.src = p.in[30]; q.src_ld = 1024; q.mode = 3; q.dst = (bf16_t*)(p.ws + OFF_WOT); q.dst_ld = 1024; q.k0 = (t & 15) * 64; q.n0 = (t >> 4) * 64; }
    else if ((t -= 256) < 1408) { q.src = p.in[31]; q.src_ld = 5632; q.dst = (bf16_t*)(p.ws + OFF_WFIT); q.dst_ld = 1024; q.k0 = (t & 15) * 64; q.n0 = (t >> 4) * 64; q.mode = 2; }
    else if ((t -= 1408) < 704) { q.src = p.in[32]; q.src_ld = 1024; q.mode = 3; q.dst = (bf16_t*)(p.ws + OFF_WFOT); q.dst_ld = 2816; q.k0 = (t % 44) * 64; q.n0 = (t / 44) * 64; }
    else if ((t -= 704) < 32) { const int tz = t >> 3; q.src = (tz >= 2 ? p.in[21] : p.in[19]) + (size_t)(tz & 1) * 64 * 512; q.src_ld = 512; q.dst = (bf16_t*)(p.ws + OFF_WUPT) + (size_t)tz * 512 * 64; q.dst_ld = 64; q.k0 = 0; q.n0 = (t & 7) * 64; }
    else { t -= 32; const int bh = t >> 3, b = bh >> 2, h = bh & 3; q.src = p.in[3] + (size_t)b * 256 * 512 + h * 128; q.src_ld = 512; q.dst = (bf16_t*)(p.ws + OFF_VTL) + (size_t)bh * 128 * 4352; q.dst_ld = 4352; q.k0 = (t & 3) * 64; q.n0 = ((t >> 2) & 1) * 64; }
    return q;
}
DI void phase_prep(const Params& p, unsigned char* ldsg) {
    const int tid = threadIdx.x;
    float* sl = (float*)ldsg;
    float* red = sl + 9216;
    for (int i = tid; i < 9216; i += 512) { const int c = i >> 10, k = i & 1023; const float v = (c < 8) ? p.in[5][c * 1024 + k] : p.in[6][k]; sl[i] = v * sigmoidf_(v); }
    __syncthreads();
    float* MOD = (float*)(p.ws + OFF_MOD);
    if (blockIdx.x == 0) {
        for (int i = tid; i < 1024; i += 512) ((unsigned*)(p.ws + OFF_CTL))[i] = 0u;
        for (int i = tid; i < 3456; i += 512) ((unsigned*)(p.ws + OFF_XBAR))[i] = 0u;
        __syncthreads();
        if (tid < 128) ((float*)(p.ws + OFF_QKW))[tid] = tid < 64 ? p.in[12][tid] : p.in[13][tid - 64]; }
    const float* ada_w = p.in[7]; const float* ada_b = p.in[8];
    for (int cc = blockIdx.x; cc < 256; cc += gridDim.x) {
        const int col = tid % 24, kg = tid / 24;
        float acc[9];
#pragma unroll
        for (int c = 0; c < 9; ++c) acc[c] = 0.f;
        if (tid < 504) {
            for (int k = kg; k < 1024; k += 21) { const float w = ada_w[(size_t)k * 6144 + cc * 24 + col];
#pragma unroll
                for (int c = 0; c < 9; ++c) acc[c] += sl[c * 1024 + k] * w; }
#pragma unroll
            for (int c = 0; c < 9; ++c) red[(kg * 24 + col) * 9 + c] = acc[c];
        }
        __syncthreads();
        if (tid < 216) { const int c = tid / 24, cl = tid % 24; float s = ada_b[cc * 24 + cl];
            for (int g = 0; g < 21; ++g) s += red[(g * 24 + cl) * 9 + c];
            MOD[c * 6144 + cc * 24 + cl] = s; }
        __syncthreads();
    }
    float* tile = (float*)ldsg;
    for (int task = blockIdx.x; task < 4384; task += 4 * gridDim.x) {
        TTask q[4];
#pragma unroll
        for (int e = 0; e < 4; ++e) { const int t = task + e * gridDim.x; if (t < 4384) { q[e] = transpose_task(p, t); transpose_load(q[e].src, q[e].src_ld, q[e].k0, q[e].n0, q[e].mode, tile + e * 4160); } }
        __syncthreads();
#pragma unroll
        for (int e = 0; e < 4; ++e) { const int t = task + e * gridDim.x; if (t < 4384) transpose_store(q[e].dst, q[e].dst_ld, q[e].k0, q[e].n0, tile + e * 4160); }
        __syncthreads();
    }
}

DI void phase_cachek(const Params& p) {
    const int tid = threadIdx.x;
    { bf16_t* KL = (bf16_t*)(p.ws + OFF_KL); const float* ck = p.in[2];
      for (int i = blockIdx.x * 512 + tid; i < 8 * 256 * 128; i += gridDim.x * 512) {
          const int b = i >> 15, rem = i & 32767, t = rem >> 7, c4 = rem & 127;
          const f32x4 v = *(const f32x4*)(ck + (size_t)i * 4);
          store_bf4(KL + ((size_t)b * 4352 + t) * 512 + c4 * 4, v[0], v[1], v[2], v[3]);
          float ss = v[0] * v[0] + v[1] * v[1] + v[2] * v[2] + v[3] * v[3];
          ss += __shfl_xor(ss, 1); ss += __shfl_xor(ss, 2); ss += __shfl_xor(ss, 4); ss += __shfl_xor(ss, 8);
          if ((c4 & 15) == 0) atomicMax((unsigned*)(p.ws + OFF_KMAX) + b * 8 + (c4 >> 4), __float_as_uint(ss * 1.02f)); } }
}

template <bool BF16IN> DI void phase_norm(const float* xa, const float* xb, const bf16_t* xh, const float* nw, const float* MOD, int sh_idx, int sc_idx, bf16_t* H) {
    const int tid = threadIdx.x, lane = tid & 63, wid = __builtin_amdgcn_readfirstlane(tid >> 6);
    const int gw = blockIdx.x * 8 + wid, nwv = gridDim.x * 8;
    const int rpw = (M_TOK + nwv - 1) / nwv; const int r0 = gw * rpw; int r1 = r0 + rpw; if (r1 > M_TOK) r1 = M_TOK;
    int cur = -1; f32x4 scl[4], shf[4];
#pragma unroll
    for (int j = 0; j < 4; ++j) { scl[j] = (f32x4){0.f, 0.f, 0.f, 0.f}; shf[j] = scl[j]; }
    for (int row = r0; row < r1; row += 4) {
        f32x4 v[4][4];
#pragma unroll
        for (int q = 0; q < 4; ++q) { const int rr = (row + q < r1) ? row + q : r1 - 1;
            if (BF16IN) {
#pragma unroll
                for (int jj = 0; jj < 2; ++jj) { const u32x4 w = *(const u32x4*)(xh + (size_t)rr * 1024 + 8 * lane + 512 * jj);
                    v[q][2 * jj] = (f32x4){__uint_as_float(w.x << 16), __uint_as_float(w.x & 0xffff0000u), __uint_as_float(w.y << 16), __uint_as_float(w.y & 0xffff0000u)};
                    v[q][2 * jj + 1] = (f32x4){__uint_as_float(w.z << 16), __uint_as_float(w.z & 0xffff0000u), __uint_as_float(w.w << 16), __uint_as_float(w.w & 0xffff0000u)}; }
            } else { const float* x = rr < M_CTX ? xa + (size_t)rr * 1024 : xb + (size_t)(rr - M_CTX) * 1024;
#pragma unroll
                for (int j = 0; j < 4; ++j) v[q][j] = *(const f32x4*)(x + 8 * lane + 512 * (j >> 1) + 4 * (j & 1)); } }
#pragma unroll
        for (int q = 0; q < 4; ++q) { const int rr = (row + q < r1) ? row + q : r1 - 1;
            const int cid = cond_of_row(rr);
            if (cid != cur) { cur = cid;
#pragma unroll
                for (int j = 0; j < 4; ++j) { const int col = 8 * lane + 512 * (j >> 1) + 4 * (j & 1);
                    const f32x4 w = *(const f32x4*)(nw + col), sc = *(const f32x4*)(MOD + cid * 6144 + sc_idx * 1024 + col);
                    scl[j] = w * (sc + 1.0f); shf[j] = *(const f32x4*)(MOD + cid * 6144 + sh_idx * 1024 + col); } }
            float ss = 0.f;
#pragma unroll
            for (int j = 0; j < 4; ++j) ss += v[q][j][0] * v[q][j][0] + v[q][j][1] * v[q][j][1] + v[q][j][2] * v[q][j][2] + v[q][j][3] * v[q][j][3];
#pragma unroll
            for (int o = 32; o >= 1; o >>= 1) ss += __shfl_xor(ss, o);
            const float rs = rsqrtf(ss * (1.0f / 1024.0f) + 1e-6f);
#pragma unroll
            for (int jj = 0; jj < 2; ++jj) store_bf8(H + (size_t)rr * 1024 + 8 * lane + 512 * jj, v[q][2 * jj] * rs * scl[2 * jj] + shf[2 * jj], v[q][2 * jj + 1] * rs * scl[2 * jj + 1] + shf[2 * jj + 1]);
        }
    }
}
#define XB_TMO      128
#define XB_XCNT(j)  (256  + 64 * (j))
#define XB_XSUB(j)  (1280 + 64 * (j))
#define XB_XGEN(j)  (2304 + 64 * (j))
#define XB_TOP      3328
#define XB_TOPGEN   3392
#define XCD_BAR_WORDS 3456
#define XB_SPIN_CAP (1u << 18)
#define XLAS __attribute__((address_space(3)))
__device__ __forceinline__ unsigned xb_ld(unsigned* p)              { return __hip_atomic_load(p, __ATOMIC_RELAXED, __HIP_MEMORY_SCOPE_AGENT); }
__device__ __forceinline__ unsigned xb_add(unsigned* p, unsigned v) { return __hip_atomic_fetch_add(p, v, __ATOMIC_RELAXED, __HIP_MEMORY_SCOPE_AGENT); }
__device__ __forceinline__ unsigned xb_xcc_id() { return (unsigned)__builtin_amdgcn_s_getreg((3 << 11) | 20) & 0xFu; }
#define XB_SPIN(cond, bar) do { unsigned _sp = 0; while (cond) { __builtin_amdgcn_s_sleep(1); \
    if ((++_sp & 255u) == 0u) { if (xb_ld(&(bar)[XB_TMO])) break; if (_sp > XB_SPIN_CAP) { atomicAdd(&(bar)[XB_TMO], 1u); break; } } } } while (0)

struct XcdBarrier {
    unsigned* bar; unsigned x;
    volatile XLAS unsigned* st;
};

__device__ __forceinline__ XcdBarrier xcd_barrier_post(unsigned* bar, volatile XLAS unsigned* st) {
    XcdBarrier b; b.bar = bar; b.x = xb_xcc_id(); b.st = st;
    if (threadIdx.x == 0) (void)xb_add(&bar[XB_XCNT(b.x)], 1u);
    return b;
}
__device__ __forceinline__ void xcd_barrier_complete(unsigned* bar, unsigned x, unsigned& nloc, unsigned& nx) {
    const unsigned G = gridDim.x * gridDim.y * gridDim.z;
    unsigned sum, cnt, mine, sp = 0u;
    for (;;) {
        sum = 0u; cnt = 0u; mine = 0u;
#pragma unroll
        for (unsigned j = 0; j < 16; ++j) { const unsigned c = xb_ld(&bar[XB_XCNT(j)]); sum += c; cnt += (c > 0u) ? 1u : 0u; mine = (j == x) ? c : mine; }
        if (sum == G) break;
        __builtin_amdgcn_s_sleep(1);
        if ((++sp & 255u) == 0u) { if (xb_ld(&bar[XB_TMO])) break; if (sp > XB_SPIN_CAP) { atomicAdd(&bar[XB_TMO], 1u); break; } }
    }
    nloc = mine > 0u ? mine : 1u; nx = cnt > 0u ? cnt : 1u;
}

__device__ __forceinline__ void xcd_barrier(const XcdBarrier& b) {
    asm volatile("s_waitcnt vmcnt(0)" ::: "memory");
    __syncthreads();
    if (threadIdx.x == 0) {
        unsigned* bar = b.bar;
        __builtin_amdgcn_s_waitcnt(0);
        unsigned nloc = b.st[0], nx = b.st[1];
        if (nloc == 0u) { xcd_barrier_complete(bar, b.x, nloc, nx); b.st[0] = nloc; b.st[1] = nx; }
        const unsigned old = xb_add(&bar[XB_XSUB(b.x)], 1u);
        const unsigned gen = old / nloc;
        if (old + 1u == (gen + 1u) * nloc) {
            __builtin_amdgcn_fence(__ATOMIC_RELEASE, "agent");
            asm volatile("s_waitcnt vmcnt(0)" ::: "memory");
            const unsigned og = xb_add(&bar[XB_TOP], 1u);
            const unsigned tg = og / nx;
            if (og + 1u == (tg + 1u) * nx) xb_add(&bar[XB_TOPGEN], 1u);
            else XB_SPIN(xb_ld(&bar[XB_TOPGEN]) == tg, bar);
            __builtin_amdgcn_fence(__ATOMIC_ACQUIRE, "agent");
            xb_add(&bar[XB_XGEN(b.x)], 1u);
            asm volatile("s_waitcnt vmcnt(0)" ::: "memory");
        } else {
            XB_SPIN(xb_ld(&bar[XB_XGEN(b.x)]) == gen, bar);
            __builtin_amdgcn_fence(__ATOMIC_ACQUIRE, "agent");
            asm volatile("s_waitcnt vmcnt(0)" ::: "memory");
        }
    }
    __syncthreads();
}

struct Epi1 {
    static constexpr bool PERM = false, AFTER_DRAIN = false, MIDK = false;
    unsigned char* ws; float* out;
    __device__ __forceinline__ void operator()(const f32x4 (&acc)[2][2][4][2], const Unit& u, int wr, int wc, int fr, int fq) const {
        asm volatile("" : "+v"(fr), "+v"(fq));
        const int pn = u.pn, pm = u.pm; const bool ctx = pm < 32;
        bf16_t* const Qb = (bf16_t*)(ws + OFF_QB); bf16_t* const KC = (bf16_t*)(ws + OFF_KC); bf16_t* const KL = (bf16_t*)(ws + OFF_KL);
        bf16_t* const VtC = (bf16_t*)(ws + OFF_VTC); bf16_t* const VtL = (bf16_t*)(ws + OFF_VTL); bf16_t* const R = (bf16_t*)(ws + OFF_R); bf16_t* const WLAL = (bf16_t*)(ws + OFF_WLAL);
        float* const newk = out + OUT_NEWK; float* const newv = out + OUT_NEWV;
        const int lr0 = wr * 64 + fr;
        const int bL = ctx ? 0 : ((pm - 32) >> 4), tL0 = ctx ? 0 : ((pm - 32) & 15) * 256;
        if (pn < 4) {
            const bool isk = pn >= 2; const float* nw = (const float*)(ws + OFF_QKW) + (isk ? 64 : 0);
            f32x4 nwv[2][2];
#pragma unroll
            for (int bj = 0; bj < 2; ++bj)
#pragma unroll
                for (int n = 0; n < 2; ++n) nwv[bj][n] = *(const f32x4*)(nw + 32 * bj + 16 * n + 4 * fq);
            float inv[4];
#pragma unroll
            for (int e = 0; e < 4; ++e) inv[e] = __builtin_amdgcn_exp2f(-(float)(4 * fq + e) * 0.830482023721841f);
            const int colbase = 256 * (pn & 1) + 64 * wc + 4 * fq;
            float kmx = 0.f;
#pragma unroll
            for (int ai = 0; ai < 2; ++ai)
#pragma unroll
                for (int m = 0; m < 4; ++m) {
                    const int lr = lr0 + ai * 128 + m * 16;
                    float ss = 0.f;
#pragma unroll
                    for (int bj = 0; bj < 2; ++bj)
#pragma unroll
                        for (int n = 0; n < 2; ++n) { const f32x4 x = acc[ai][bj][m][n]; ss += x[0] * x[0] + x[1] * x[1] + x[2] * x[2] + x[3] * x[3]; }
                    ss += __shfl_xor(ss, 16); ss += __shfl_xor(ss, 32);
                    const float rs = rsqrtf(ss * (1.0f / 64.0f) + 1e-6f);
                    f32x4 val[2][2];
#pragma unroll
                    for (int bj = 0; bj < 2; ++bj)
#pragma unroll
                        for (int n = 0; n < 2; ++n) val[bj][n] = acc[ai][bj][m][n] * rs * nwv[bj][n];
                    if (!ctx) {
                        const int t = tL0 + lr;
#pragma unroll
                        for (int bj = 0; bj < 2; ++bj) { const float pos = (float)(bj ? (t & 63) : (t >> 6));
#pragma unroll
                            for (int e = 0; e < 4; ++e) { const float ang = pos * inv[e]; const float sn = __sinf(ang), cs = __cosf(ang);
                                const float x1 = val[bj][0][e], x2 = val[bj][1][e]; val[bj][0][e] = x1 * cs - x2 * sn; val[bj][1][e] = x1 * sn + x2 * cs; } }
                    }
                    const size_t row = (size_t)pm * 256 + lr;
                    if (isk) { float s2 = 0.f;
#pragma unroll
                        for (int bj = 0; bj < 2; ++bj)
#pragma unroll
                            for (int n = 0; n < 2; ++n) { const f32x4 v = val[bj][n]; s2 += v[0] * v[0] + v[1] * v[1] + v[2] * v[2] + v[3] * v[3]; }
                        s2 += __shfl_xor(s2, 16); s2 += __shfl_xor(s2, 32);
                        kmx = fmaxf(kmx, s2); }
#pragma unroll
                    for (int bj = 0; bj < 2; ++bj)
#pragma unroll
                        for (int n = 0; n < 2; ++n) { const int col = colbase + 32 * bj + 16 * n; const f32x4 v = val[bj][n];
                            if (!isk) { const float qsc = 0.125f * LOG2E; store_bf4(Qb + row * 512 + col, v[0] * qsc, v[1] * qsc, v[2] * qsc, v[3] * qsc); }
                            else if (ctx) { store_bf4(KC + row * 512 + col, v[0], v[1], v[2], v[3]); *(f32x4*)(newk + row * 512 + col) = v; }
                            else store_bf4(KL + ((size_t)bL * 4352 + 256 + tL0 + lr) * 512 + col, v[0], v[1], v[2], v[3]); }
                    asm volatile("" ::: "memory"); __builtin_amdgcn_sched_barrier(0);
                }
            if (isk) {
                kmx = fmaxf(kmx, __shfl_xor(kmx, 1)); kmx = fmaxf(kmx, __shfl_xor(kmx, 2)); kmx = fmaxf(kmx, __shfl_xor(kmx, 4)); kmx = fmaxf(kmx, __shfl_xor(kmx, 8));
                if (fr == 0 && fq == 0) { const int hm = 4 * (pn & 1) + wc;
                    atomicMax((unsigned*)(ws + OFF_KMAX) + (ctx ? 64 + pm * 8 : bL * 8) + hm, __float_as_uint(kmx * 1.02f)); }
            }
        } else if (pn < 6) {
#pragma unroll
            for (int ai = 0; ai < 2; ++ai)
#pragma unroll
                for (int m = 0; m < 4; ++m) { const int lr = lr0 + ai * 128 + m * 16; const size_t row = (size_t)pm * 256 + lr;
#pragma unroll
                    for (int bj = 0; bj < 2; ++bj) { const int h = 2 * (pn - 4) + bj;
#pragma unroll
                        for (int n = 0; n < 2; ++n) { const int d0 = 32 * wc + 16 * n + 4 * fq; const f32x4 v = acc[ai][bj][m][n];
                            if (ctx) { bf16_t* vp = VtC + ((size_t)(pm * 4 + h) * 128 + d0) * 256 + lr;
#pragma unroll
                                for (int e = 0; e < 4; ++e) vp[(size_t)e * 256] = f2bf(v[e]);
                                *(f32x4*)(newv + row * 512 + 256 * (pn - 4) + 128 * bj + d0) = v; }
                            else { bf16_t* vp = VtL + ((size_t)(bL * 4 + h) * 128 + d0) * 4352 + 256 + tL0 + lr;
#pragma unroll
                                for (int e = 0; e < 4; ++e) vp[(size_t)e * 4352] = f2bf(v[e]); } } }
                    asm volatile("" ::: "memory"); __builtin_amdgcn_sched_barrier(0); }
        } else if (pn < 14) {
            const int which = (pn - 6) >> 1; bf16_t* dst = R + (size_t)which * M_TOK * 512;
            const int cb = 256 * ((pn - 6) & 1) + 32 * wc + 8 * fq;
#pragma unroll
            for (int ai = 0; ai < 2; ++ai)
#pragma unroll
                for (int m = 0; m < 4; ++m) { const size_t row = (size_t)pm * 256 + lr0 + ai * 128 + m * 16;
#pragma unroll
                    for (int bj = 0; bj < 2; ++bj) {
                        if (which == 3) {
                            f32x4 t0 = acc[ai][bj][m][0], t1 = acc[ai][bj][m][1];
#pragma unroll
                            for (int e = 0; e < 4; ++e) { t0[e] = sigmoidf_(t0[e]) * 255.0f + 0.5f; t1[e] = sigmoidf_(t1[e]) * 255.0f + 0.5f; }
                            u32x2 w; w.x = (unsigned)t0[0] | ((unsigned)t0[1] << 8) | ((unsigned)t0[2] << 16) | ((unsigned)t0[3] << 24);
                            w.y = (unsigned)t1[0] | ((unsigned)t1[1] << 8) | ((unsigned)t1[2] << 16) | ((unsigned)t1[3] << 24);
                            *(u32x2*)((unsigned char*)dst + row * 512 + cb + 128 * bj) = w;
                        } else store_bf8(dst + row * 512 + cb + 128 * bj, acc[ai][bj][m][0], acc[ai][bj][m][1]); }
                    asm volatile("" ::: "memory"); __builtin_amdgcn_sched_barrier(0); }
        } else if (pn == 14) {
            const int cb = 32 * wc + 8 * fq;
#pragma unroll
            for (int ai = 0; ai < 2; ++ai)
#pragma unroll
                for (int m = 0; m < 4; ++m) { const size_t row = (size_t)pm * 256 + lr0 + ai * 128 + m * 16;
                    { f32x4 t0 = acc[ai][0][m][0], t1 = acc[ai][0][m][1];
#pragma unroll
                      for (int e = 0; e < 4; ++e) { t0[e] = tanhf_(t0[e]); t1[e] = tanhf_(t1[e]); }
                      store_bf8(WLAL + row * 256 + cb, t0, t1); store_bf8(WLAL + row * 256 + 128 + cb, acc[ai][1][m][0], acc[ai][1][m][1]); }
                    asm volatile("" ::: "memory"); __builtin_amdgcn_sched_barrier(0); }
        } else {
            unsigned char* const G = (unsigned char*)out; const int cb = 256 * (pn - 15) + 32 * wc + 8 * fq;
#pragma unroll
            for (int ai = 0; ai < 2; ++ai)
#pragma unroll
                for (int m = 0; m < 4; ++m) { const size_t row = (size_t)pm * 256 + lr0 + ai * 128 + m * 16;
#pragma unroll
                    for (int bj = 0; bj < 2; ++bj) { f32x4 t0 = acc[ai][bj][m][0], t1 = acc[ai][bj][m][1];
#pragma unroll
                        for (int e = 0; e < 4; ++e) { t0[e] = sigmoidf_(t0[e]) * 255.0f + 0.5f; t1[e] = sigmoidf_(t1[e]) * 255.0f + 0.5f; }
                        u32x2 w; w.x = (unsigned)t0[0] | ((unsigned)t0[1] << 8) | ((unsigned)t0[2] << 16) | ((unsigned)t0[3] << 24);
                        w.y = (unsigned)t1[0] | ((unsigned)t1[1] << 8) | ((unsigned)t1[2] << 16) | ((unsigned)t1[3] << 24);
                        *(u32x2*)(G + row * 2048 + cb + 128 * bj) = w; }
                    asm volatile("" ::: "memory"); __builtin_amdgcn_sched_barrier(0); }
        }
    }
};
struct EpiMerge1 {
    static constexpr bool PERM = false, AFTER_DRAIN = false, MIDK = true;
    const unsigned char* G; bf16_t* MG;
    __device__ __forceinline__ void mid(f32x4 (&acc)[2][2][4][2], const Unit& u, int wr, int wc, int fr, int fq) const {
        asm volatile("" : "+v"(fr), "+v"(fq));
        const int row0 = u.pm * 256 + wr * 64 + fr, col0 = u.pn * 256 + wc * 32 + 8 * fq;
#pragma unroll
        for (int ai = 0; ai < 2; ++ai)
#pragma unroll
            for (int m = 0; m < 4; ++m) { const unsigned char* gp = G + (size_t)(row0 + ai * 128 + m * 16) * 2048 + col0;
#pragma unroll
                for (int bj = 0; bj < 2; ++bj) { const u32x2 ga = *(const u32x2*)(gp + bj * 128), gr = *(const u32x2*)(gp + 1024 + bj * 128);
#pragma unroll
                    for (int n = 0; n < 2; ++n)
#pragma unroll
                        for (int e = 0; e < 4; ++e) { const float a = (float)(((n ? ga.y : ga.x) >> (8 * e)) & 255u), r = fmaxf((float)(((n ? gr.y : gr.x) >> (8 * e)) & 255u), 1.0f);
                            acc[ai][bj][m][n][e] *= a * __builtin_amdgcn_rcpf(r); } }
                asm volatile("" ::: "memory"); }
    }
    __device__ __forceinline__ void operator()(const f32x4 (&acc)[2][2][4][2], const Unit& u, int wr, int wc, int fr, int fq) const {
        asm volatile("" : "+v"(fr), "+v"(fq));
        const int row0 = u.pm * 256 + wr * 64 + fr, col0 = u.pn * 256 + wc * 32 + 8 * fq;
#pragma unroll
        for (int ai = 0; ai < 2; ++ai)
#pragma unroll
            for (int m = 0; m < 4; ++m) { const size_t row = (size_t)(row0 + ai * 128 + m * 16);
#pragma unroll
                for (int bj = 0; bj < 2; ++bj) { const u32x2 gr = *(const u32x2*)(G + row * 2048 + 1024 + col0 + bj * 128);
                    f32x4 o[2];
#pragma unroll
                    for (int n = 0; n < 2; ++n)
#pragma unroll
                        for (int e = 0; e < 4; ++e) o[n][e] = acc[ai][bj][m][n][e] * (fmaxf((float)(((n ? gr.y : gr.x) >> (8 * e)) & 255u), 1.0f) * (1.0f / 255.0f));
                    store_bf8(MG + row * 1024 + col0 + bj * 128, o[0], o[1]); }
                asm volatile("" ::: "memory"); }
    }
};
template <int MODE> struct EpiResid {
    static constexpr bool PERM = false, AFTER_DRAIN = false, MIDK = false;
    const float *xa, *xb; float* out; const float* MOD; int gidx; bf16_t* X1b;
    __device__ __forceinline__ void operator()(const f32x4 (&acc)[2][2][4][2], const Unit& u, int wr, int wc, int fr, int fq) const {
        asm volatile("" : "+v"(fr), "+v"(fq));
        const int row0 = u.pm * 256 + wr * 64 + fr, col0 = u.pn * 256 + wc * 32 + 8 * fq;
        const int cid = u.pm < 32 ? 8 : ((u.pm - 32) >> 4);
        f32x4 g[2][2];
#pragma unroll
        for (int bj = 0; bj < 2; ++bj)
#pragma unroll
            for (int n = 0; n < 2; ++n) g[bj][n] = *(const f32x4*)(MOD + cid * 6144 + gidx * 1024 + col0 + bj * 128 + n * 4);
#pragma unroll
        for (int ai = 0; ai < 2; ++ai)
#pragma unroll
            for (int m = 0; m < 4; ++m) { const int row = row0 + ai * 128 + m * 16; const size_t off = (size_t)row * 1024 + col0;
                const float* xs = u.pm < 32 ? xa + off : xb + (off - (size_t)M_CTX * 1024);
#pragma unroll
                for (int bj = 0; bj < 2; ++bj) { const size_t o2 = off + bj * 128;
                    if (MODE == 0) { const f32x4 x0 = *(const f32x4*)(xs + bj * 128), x1 = *(const f32x4*)(xs + bj * 128 + 4);
                        store_bf8(X1b + o2, x0 + g[bj][0] * acc[ai][bj][m][0], x1 + g[bj][1] * acc[ai][bj][m][1]); }
                    else { const u32x4 w = *(const u32x4*)(X1b + o2);
                        const f32x4 x0 = {__uint_as_float(w.x << 16), __uint_as_float(w.x & 0xffff0000u), __uint_as_float(w.y << 16), __uint_as_float(w.y & 0xffff0000u)};
                        const f32x4 x1 = {__uint_as_float(w.z << 16), __uint_as_float(w.z & 0xffff0000u), __uint_as_float(w.w << 16), __uint_as_float(w.w & 0xffff0000u)};
                        *(f32x4*)(out + o2) = x0 + g[bj][0] * acc[ai][bj][m][0]; *(f32x4*)(out + o2 + 4) = x1 + g[bj][1] * acc[ai][bj][m][1]; } } }
    }
};
struct EpiSwiGLU {
    static constexpr bool PERM = false, AFTER_DRAIN = false, MIDK = false;
    bf16_t* ACT;
    __device__ __forceinline__ void operator()(const f32x4 (&acc)[2][2][4][2], const Unit& u, int wr, int wc, int fr, int fq) const {
        asm volatile("" : "+v"(fr), "+v"(fq));
        const int row0 = u.pm * 256 + wr * 64 + fr, col0 = u.pn * 128 + wc * 32 + 8 * fq;
#pragma unroll
        for (int ai = 0; ai < 2; ++ai)
#pragma unroll
            for (int m = 0; m < 4; ++m) { bf16_t* rp = ACT + (size_t)(row0 + ai * 128 + m * 16) * 2816 + col0;
                f32x4 t[2];
#pragma unroll
                for (int n = 0; n < 2; ++n) { const f32x4 a = acc[ai][0][m][n], g = acc[ai][1][m][n];
#pragma unroll
                    for (int e = 0; e < 4; ++e) t[n][e] = a[e] * sigmoidf_(a[e]) * g[e]; }
                store_bf8(rp, t[0], t[1]); }
    }
};
template <int CTRL> DI float dpp_add(float x) { const int y = __builtin_amdgcn_update_dpp(0, __float_as_int(x), CTRL, 0xF, 0xF, true); return x + __int_as_float(y); }
DI float red16(float x) { x = dpp_add<0xB1>(x); x = dpp_add<0x4E>(x); x = dpp_add<0x141>(x); x = dpp_add<0x140>(x); return x; }
DI float dot4(const f32x4 a, const f32x4 b) { return (a[0] * b[0] + a[1] * b[1]) + (a[2] * b[2] + a[3] * b[3]); }

#define LBAR() do { asm volatile("s_waitcnt lgkmcnt(0)" ::: "memory"); __builtin_amdgcn_s_barrier(); asm volatile("" ::: "memory"); } while (0)
#define RDL(x, l) __int_as_float(__builtin_amdgcn_readlane(__float_as_int(x), (l)))
DI bf16x8 ldfrag(const bf16_t* base, int row, int pitch, int col) { return *(const bf16x8*)(base + row * pitch + col); }
DI void scan_chain(const Params& p, unsigned char* ldsg, bool latent, int b, int z, int h) {
    int tid = threadIdx.x; asm volatile("" : "+v"(tid));
    const int lane = tid & 63, wid = __builtin_amdgcn_readfirstlane(tid >> 6), l15 = lane & 15, quad = lane >> 4;
    const int T = latent ? 4096 : 256, rowbase = latent ? M_CTX + b * 4096 : b * 256, nchunk = T >> 5;
    float* AW0 = (float*)ldsg; float* AW1 = AW0 + 2048; float* CUM = AW0 + 4096;
    bf16_t* KKt = (bf16_t*)(ldsg + 24576);
    bf16_t* S0b = (bf16_t*)(ldsg + 43008);
    bf16_t* VT = (bf16_t*)(ldsg + 52224);
    bf16_t* KDT = (bf16_t*)(ldsg + 57344);
    bf16_t* BBT = (bf16_t*)(ldsg + 62464);
    bf16_t* A1T = (bf16_t*)(ldsg + 67584);
    float* A2f = (float*)(ldsg + 75264);
    float* RHSf = (float*)(ldsg + 79360);
    bf16_t* Ub = (bf16_t*)(ldsg + 88576);
    float* CL = (float*)(ldsg + 93696);
    const bf16_t* R = (const bf16_t*)(p.ws + OFF_R); const bf16_t* Kr = (const bf16_t*)(p.ws + OFF_KR); const bf16_t* Vr = (const bf16_t*)(p.ws + OFF_VR);
    const bf16_t* WLAL = (const bf16_t*)(p.ws + OFF_WLAL); const bf16_t* WUPT = (const bf16_t*)(p.ws + OFF_WUPT);
    float* BS = (float*)(p.ws + OFF_BS); bf16_t* Y = (bf16_t*)(p.ws + OFF_H1);
    const int type = wid >> 2, ntile = wid & 3;
    bf16x8 bw[2];
#pragma unroll
    for (int ks = 0; ks < 2; ++ks) bw[ks] = *(const bf16x8*)(WUPT + ((size_t)(type * 2 + z) * 512 + h * 64 + ntile * 16 + l15) * 64 + ks * 32 + quad * 8);
    const float bias0 = (type == 0 ? p.in[20] : p.in[22])[z * 512 + h * 64 + ntile * 16 + l15];
    const int te = tid >> 4, c4 = (tid & 15) * 4, hc = h * 64 + c4;
    const f32x4 kkc = *(const f32x4*)(p.in[23] + hc), kac = *(const f32x4*)(p.in[24] + hc), rkc = *(const f32x4*)(p.in[25] + hc);
    const int vt = wid >> 1, kt0 = 2 * (wid & 1);
    f32x4 S[2];
#pragma unroll
    for (int q = 0; q < 2; ++q)
#pragma unroll
        for (int j = 0; j < 4; ++j) { const int v = vt * 16 + quad * 4 + j, k = (kt0 + q) * 16 + l15;
            S[q][j] = latent ? p.in[4][((size_t)((b * 2 + z) * 8 + h)) * 4096 + v * 64 + k] : 0.f;
            S0b[v * 72 + k] = f2bf(S[q][j]); }
    bf16x8 af[2][2]; u32x2 kreg, rreg, vreg;
#define SCAN_TOK(idx) (rowbase + (z ? (T - 1 - (idx)) : (idx)))
    const long cstep = z ? -32 : 32;
    const bf16_t* pw0 = WLAL + (size_t)SCAN_TOK(l15) * 256 + type * 128 + z * 64 + quad * 8;
    const bf16_t* pw1 = WLAL + (size_t)SCAN_TOK(16 + l15) * 256 + type * 128 + z * 64 + quad * 8;
    const bf16_t* pk = Kr + (size_t)SCAN_TOK(te) * 512 + hc;
    const long offR = (long)(R - Kr), offV = (long)(Vr - Kr);
#define SCAN_PREFETCH(n) do { \
        af[0][0] = *(const bf16x8*)(pw0); af[0][1] = *(const bf16x8*)(pw0 + 32); af[1][0] = *(const bf16x8*)(pw1); af[1][1] = *(const bf16x8*)(pw1 + 32); \
        kreg = *(const u32x2*)(pk); rreg = *(const u32x2*)(pk + offR); vreg = *(const u32x2*)(pk + offV); \
        pw0 += cstep * 256; pw1 += cstep * 256; pk += cstep * 512; } while (0)
    SCAN_PREFETCH(0);
    for (int n = 0; n < nchunk; ++n) {
        int L15 = l15, QD = quad, TE = te, C4 = c4, LN = lane;
        asm volatile("" : "+v"(L15), "+v"(QD), "+v"(TE), "+v"(C4), "+v"(LN));
        { float Lv[2][4];
#pragma unroll
          for (int mt = 0; mt < 2; ++mt) { f32x4 acc = {0.f, 0.f, 0.f, 0.f};
              acc = __builtin_amdgcn_mfma_f32_16x16x32_bf16(af[mt][0], bw[0], acc, 0, 0, 0);
              acc = __builtin_amdgcn_mfma_f32_16x16x32_bf16(af[mt][1], bw[1], acc, 0, 0, 0);
#pragma unroll
              for (int j = 0; j < 4; ++j) { const float sg = sigmoidf_(acc[j] + bias0); Lv[mt][j] = type == 0 ? -0.6065306597126334f * LOG2E * sg : sg; } }
          if (type == 0) {
              float base = 0.f;
#pragma unroll
              for (int mt = 0; mt < 2; ++mt) {
                  const float p0 = Lv[mt][0], p1 = p0 + Lv[mt][1], p2 = p1 + Lv[mt][2], p3 = p2 + Lv[mt][3];
                  float sq = p3;
                  const float u1 = __shfl_up(sq, 16); if (QD >= 1) sq += u1;
                  const float u2 = __shfl_up(sq, 32); if (QD >= 2) sq += u2;
                  const float ex = base + (sq - p3);
                  const int idx = (mt * 16 + QD * 4) * 64 + ntile * 16 + L15;
                  AW0[idx] = Lv[mt][0]; AW0[idx + 64] = Lv[mt][1]; AW0[idx + 128] = Lv[mt][2]; AW0[idx + 192] = Lv[mt][3];
                  CUM[idx] = ex + p0; CUM[idx + 64] = ex + p1; CUM[idx + 128] = ex + p2; CUM[idx + 192] = ex + p3;
                  base += __shfl(sq, 48 + L15);
              }
          } else {
#pragma unroll
              for (int mt = 0; mt < 2; ++mt)
#pragma unroll
                  for (int j = 0; j < 4; ++j) AW1[(mt * 16 + QD * 4 + j) * 64 + ntile * 16 + L15] = Lv[mt][j];
          } }
        LBAR();
        { const int tok = SCAN_TOK(n * 32 + TE);
          float kv[4], rv[4];
          kv[0] = __uint_as_float(kreg.x << 16); kv[1] = __uint_as_float(kreg.x & 0xffff0000u); kv[2] = __uint_as_float(kreg.y << 16); kv[3] = __uint_as_float(kreg.y & 0xffff0000u);
          rv[0] = __uint_as_float(rreg.x << 16); rv[1] = __uint_as_float(rreg.x & 0xffff0000u); rv[2] = __uint_as_float(rreg.y << 16); rv[3] = __uint_as_float(rreg.y & 0xffff0000u);
          float qv[4]; float ss = 0.f;
#pragma unroll
          for (int e = 0; e < 4; ++e) { qv[e] = kv[e] * kkc[e]; ss += qv[e] * qv[e]; }
          ss = red16(ss);
          const float invn = rsqrtf(fmaxf(ss, 1e-24f));
          const f32x4 aa = *(const f32x4*)(AW1 + TE * 64 + C4), Lw = *(const f32x4*)(AW0 + TE * 64 + C4), Lc = *(const f32x4*)(CUM + TE * 64 + C4);
          float KKv[4], RRv[4], KDv[4], BBv[4], ctv[4]; float bon = 0.f;
#pragma unroll
          for (int e = 0; e < 4; ++e) { const float ct = __builtin_amdgcn_exp2f(Lc[e]), cprev = __builtin_amdgcn_exp2f(Lc[e] - Lw[e]), ic = __builtin_amdgcn_exp2f(-Lc[e]);
              const float kn = qv[e] * invn, bb = kn * aa[e], kd = kv[e] * (1.0f + (aa[e] - 1.0f) * kac[e]);
              bon += rv[e] * kd * rkc[e];
              KKv[e] = kn * cprev; RRv[e] = rv[e] * ct; KDv[e] = kd * ic; BBv[e] = bb * ic;
              ctv[e] = ct; }
          if (TE == 31) *(f32x4*)(CL + C4) = (f32x4){ctv[0], ctv[1], ctv[2], ctv[3]};
          bon = red16(bon);
          if ((tid & 15) == 0) BS[((size_t)z * M_TOK + tok) * 8 + h] = bon;
          store_bf4(KKt + TE * 72 + C4, KKv[0], KKv[1], KKv[2], KKv[3]); store_bf4(KKt + 2304 + TE * 72 + C4, RRv[0], RRv[1], RRv[2], RRv[3]);
          store_bf4(KKt + 4608 + TE * 72 + C4, KDv[0], KDv[1], KDv[2], KDv[3]); store_bf4(KKt + 6912 + TE * 72 + C4, BBv[0], BBv[1], BBv[2], BBv[3]);
#pragma unroll
          for (int e = 0; e < 4; ++e) { KDT[(C4 + e) * 40 + TE] = f2bf(KDv[e]); BBT[(C4 + e) * 40 + TE] = f2bf(-BBv[e]); }
          VT[(C4 + 0) * 40 + TE] = (bf16_t)(vreg.x & 0xffffu); VT[(C4 + 1) * 40 + TE] = (bf16_t)(vreg.x >> 16); VT[(C4 + 2) * 40 + TE] = (bf16_t)(vreg.y & 0xffffu); VT[(C4 + 3) * 40 + TE] = (bf16_t)(vreg.y >> 16); }
        if (n + 1 < nchunk) SCAN_PREFETCH(n + 1);
        LBAR();
        f32x4 P[2];
        { const int am = wid >> 1;
          const bf16_t* X = KKt + 4608 + (am & 1) * 2304; const bf16_t* Yt = KKt + (am >> 1) * 2304;
          bf16_t* AT = A1T + (am == 0 ? 0 : am == 2 ? 1280 : 2560);
          const bool strict = am < 2; const float sgn = am == 3 ? -1.0f : 1.0f;
#pragma unroll
          for (int tl = 0; tl < 2; ++tl) {
              const int it = (wid & 1) ? tl : tl, tt = (wid & 1) ? 1 - tl : tl;
              f32x4 acc = {0.f, 0.f, 0.f, 0.f};
              if (!((wid & 1) && tl == 1)) {
#pragma unroll
                  for (int ks = 0; ks < 2; ++ks) acc = __builtin_amdgcn_mfma_f32_16x16x32_bf16(ldfrag(X, it * 16 + L15, 72, ks * 32 + QD * 8), ldfrag(Yt, tt * 16 + L15, 72, ks * 32 + QD * 8), acc, 0, 0, 0);
              }
              const int t = tt * 16 + L15, i0 = it * 16 + QD * 4;
              float o[4];
#pragma unroll
              for (int j = 0; j < 4; ++j) { const int i = i0 + j; const bool keep = strict ? (i < t) : (i <= t); o[j] = keep ? acc[j] * sgn : 0.f; }
              if (am == 1) { const int tp = (t & 15) * 2 + (t >> 4); A2f[(i0 + 0) * 32 + tp] = o[0]; A2f[(i0 + 1) * 32 + tp] = o[1]; A2f[(i0 + 2) * 32 + tp] = o[2]; A2f[(i0 + 3) * 32 + tp] = o[3]; }
              else store_bf4(AT + t * 40 + i0, o[0], o[1], o[2], o[3]);
          } }
        { const int which = wid >> 2, mt = wid & 3; const bf16_t* Yt = KKt + which * 2304;
#pragma unroll
          for (int nt = 0; nt < 2; ++nt) { f32x4 acc = {0.f, 0.f, 0.f, 0.f};
#pragma unroll
              for (int ks = 0; ks < 2; ++ks) acc = __builtin_amdgcn_mfma_f32_16x16x32_bf16(ldfrag(S0b, mt * 16 + L15, 72, ks * 32 + QD * 8), ldfrag(Yt, nt * 16 + L15, 72, ks * 32 + QD * 8), acc, 0, 0, 0);
              P[nt] = acc; } }
        LBAR();
        if (wid < 4) { const int mt = wid;
#pragma unroll
            for (int nt = 0; nt < 2; ++nt) { P[nt] = __builtin_amdgcn_mfma_f32_16x16x32_bf16(ldfrag(VT, mt * 16 + L15, 40, QD * 8), ldfrag(A1T, nt * 16 + L15, 40, QD * 8), P[nt], 0, 0, 0);
#pragma unroll
                for (int j = 0; j < 4; ++j) RHSf[(mt * 16 + QD * 4 + j) * 36 + nt * 16 + L15] = P[nt][j]; } }
        else { const int mt = wid & 3;
#pragma unroll
            for (int nt = 0; nt < 2; ++nt) P[nt] = __builtin_amdgcn_mfma_f32_16x16x32_bf16(ldfrag(VT, mt * 16 + L15, 40, QD * 8), ldfrag(A1T + 1280, nt * 16 + L15, 40, QD * 8), P[nt], 0, 0, 0); }
        LBAR();
        {
            const int t16 = LN & 15, r4 = LN >> 4;
            const int rowA = wid * 8 + r4, rowB = rowA + 4;
            float aL = RHSf[rowA * 36 + t16], aH = RHSf[rowA * 36 + 16 + t16], bL = RHSf[rowB * 36 + t16], bH = RHSf[rowB * 36 + 16 + t16];
#define BC(x, i) __int_as_float(__builtin_amdgcn_update_dpp(0, __float_as_int(x), 0x150 + (i), 0xF, 0xF, true))
#define SOLVE1(i) { const f32x2_t cc = *(const f32x2_t*)(A2f + (i) * 32 + t16 * 2); const float c0 = cc.x, c1 = cc.y; const float ua = BC(aL, i), ub = BC(bL, i); \
                if ((i) < 15) { aL -= ua * c0; bL -= ub * c0; } aH -= ua * c1; bH -= ub * c1; }
#define SOLVE2(i) { const float c1 = A2f[(16 + (i)) * 32 + t16 * 2 + 1]; const float ua = BC(aH, i), ub = BC(bH, i); aH -= ua * c1; bH -= ub * c1; }
            SOLVE1(0) SOLVE1(1) SOLVE1(2) SOLVE1(3) SOLVE1(4) SOLVE1(5) SOLVE1(6) SOLVE1(7) SOLVE1(8) SOLVE1(9) SOLVE1(10) SOLVE1(11) SOLVE1(12) SOLVE1(13) SOLVE1(14) SOLVE1(15)
            SOLVE2(0) SOLVE2(1) SOLVE2(2) SOLVE2(3) SOLVE2(4) SOLVE2(5) SOLVE2(6) SOLVE2(7) SOLVE2(8) SOLVE2(9) SOLVE2(10) SOLVE2(11) SOLVE2(12) SOLVE2(13) SOLVE2(14)
#undef SOLVE1
#undef SOLVE2
#undef BC
            Ub[rowA * 40 + t16] = f2bf(aL); Ub[rowA * 40 + 16 + t16] = f2bf(aH); Ub[rowB * 40 + t16] = f2bf(bL); Ub[rowB * 40 + 16 + t16] = f2bf(bH); }
        LBAR();
        if (wid >= 4) { const int mt = wid & 3;
#pragma unroll
            for (int nt = 0; nt < 2; ++nt) {
                P[nt] = __builtin_amdgcn_mfma_f32_16x16x32_bf16(ldfrag(Ub, mt * 16 + L15, 40, QD * 8), ldfrag(A1T + 2560, nt * 16 + L15, 40, QD * 8), P[nt], 0, 0, 0);
                const int tok = SCAN_TOK(n * 32 + nt * 16 + L15);
                store_bf4(Y + ((size_t)z * M_TOK + tok) * 512 + h * 64 + mt * 16 + QD * 4, P[nt][0], P[nt][1], P[nt][2], P[nt][3]); } }
#pragma unroll
        for (int q = 0; q < 2; ++q) { const int kt = kt0 + q;
            S[q] = __builtin_amdgcn_mfma_f32_16x16x32_bf16(ldfrag(VT, vt * 16 + L15, 40, QD * 8), ldfrag(KDT, kt * 16 + L15, 40, QD * 8), S[q], 0, 0, 0);
            S[q] = __builtin_amdgcn_mfma_f32_16x16x32_bf16(ldfrag(Ub, vt * 16 + L15, 40, QD * 8), ldfrag(BBT, kt * 16 + L15, 40, QD * 8), S[q], 0, 0, 0);
            const float cl = CL[kt * 16 + L15];
#pragma unroll
            for (int j = 0; j < 4; ++j) { S[q][j] *= cl; S0b[(vt * 16 + QD * 4 + j) * 72 + kt * 16 + L15] = f2bf(S[q][j]); } }
    }
    LBAR();
    if (!latent) { float* so = p.out + OUT_STATE + ((size_t)((b * 2 + z) * 8 + h)) * 4096;
#pragma unroll
        for (int q = 0; q < 2; ++q)
#pragma unroll
            for (int j = 0; j < 4; ++j) so[(vt * 16 + quad * 4 + j) * 64 + (kt0 + q) * 16 + l15] = S[q][j]; }
    __syncthreads();
#undef SCAN_PREFETCH
#undef SCAN_TOK
}

DI void attn_unit(const Params& p, unsigned char* ldsg, bool latent, int b, int h, int qb, float lam) {
    int tid = threadIdx.x; asm volatile("" : "+v"(tid));
    const int lane = tid & 63, wid = __builtin_amdgcn_readfirstlane(tid >> 6), r = lane & 31, hh = lane >> 5, qg = wid & 3, mp = wid >> 2;
    const int Tk = latent ? 4352 : 256, NT = Tk >> 6;
    const size_t qrow0 = (size_t)(latent ? M_CTX + b * 4096 : b * 256) + qb * 128;
    const bf16_t* Qb = (const bf16_t*)(p.ws + OFF_QB);
    const bf16_t* Kg = (latent ? (const bf16_t*)(p.ws + OFF_KL) + (size_t)b * 4352 * 512 : (const bf16_t*)(p.ws + OFF_KC) + (size_t)b * 256 * 512) + h * 128;
    const bf16_t* Vg = latent ? (const bf16_t*)(p.ws + OFF_VTL) + (size_t)(b * 4 + h) * 128 * 4352 : (const bf16_t*)(p.ws + OFF_VTC) + (size_t)(b * 4 + h) * 128 * 256;
    bf16x8 qf[4];
#pragma unroll
    for (int kk = 0; kk < 4; ++kk) qf[kk] = *(const bf16x8*)(Qb + (qrow0 + 32 * qg + r) * 512 + h * 128 + mp * 64 + 16 * kk + 8 * hh);
    const int krow = tid >> 3, kch = tid & 7, vrow = tid >> 2, vch = tid & 3;
    const bf16_t* kgp = Kg + (size_t)krow * 512 + kch * 8;
    const bf16_t* vgp = Vg + (size_t)vrow * Tk + vch * 8;
    unsigned char* kl = ldsg + krow * 272 + kch * 16;
    unsigned char* vl = ldsg + 34816 + vrow * 144 + (vch >> 1) * 32 + (vch & 1) * 8;
    u32x4 kr0, kr1, vr0, vr1;
#define ATT_LOAD(j) do { kr0 = *(const u32x4*)(kgp + (size_t)(j) * 64 * 512); kr1 = *(const u32x4*)(kgp + (size_t)(j) * 64 * 512 + 64); vr0 = *(const u32x4*)(vgp + (size_t)(j) * 64); vr1 = *(const u32x4*)(vgp + (size_t)(j) * 64 + 32); } while (0)
#define ATT_STORE(bf) do { *(u32x4*)(kl + (bf) * 17408) = kr0; *(u32x4*)(kl + (bf) * 17408 + 128) = kr1; \
        *(u32x2*)(vl + (bf) * 18432) = (u32x2){vr0.x, vr0.y}; *(u32x2*)(vl + (bf) * 18432 + 16) = (u32x2){vr0.z, vr0.w}; \
        *(u32x2*)(vl + (bf) * 18432 + 64) = (u32x2){vr1.x, vr1.y}; *(u32x2*)(vl + (bf) * 18432 + 80) = (u32x2){vr1.z, vr1.w}; } while (0)
    ATT_LOAD(0);
    f32x16 o[4];
#pragma unroll
    for (int d = 0; d < 4; ++d)
#pragma unroll
        for (int i = 0; i < 16; ++i) o[d][i] = 0.f;
    float lsum = 0.f;
    const float CS = 0.125f * LOG2E;
    float mref;
    { float qs = 0.f;
#pragma unroll
      for (int kk = 0; kk < 4; ++kk)
#pragma unroll
          for (int j = 0; j < 8; ++j) { const float x = bf2f((unsigned short)qf[kk][j]); qs += x * x; }
      qs += __shfl_xor(qs, 32);
      const float kmax2 = __uint_as_float(((const unsigned*)(p.ws + OFF_KMAX))[(latent ? b * 8 : 64 + b * 8) + h * 2 + mp]);
      mref = sqrtf(qs * kmax2); }
    f32x16 negm;
#pragma unroll
    for (int i = 0; i < 16; ++i) negm[i] = -mref;
    ATT_STORE(0);
    __syncthreads();
    for (int j = 0; j < NT; ++j) {
        const int bf = j & 1;
        if (j + 1 < NT) ATT_LOAD(j + 1);
        const unsigned char* kb = ldsg + bf * 17408 + r * 272 + (mp * 64 + 8 * hh) * 2;
        const unsigned char* vb = ldsg + 34816 + bf * 18432 + r * 144 + 16 * hh;
        f32x16 st[2];
#pragma unroll
        for (int kt = 0; kt < 2; ++kt) {
            st[kt] = negm;
#pragma unroll
            for (int kk = 0; kk < 4; ++kk) { const bf16x8 kf = *(const bf16x8*)(kb + kt * 32 * 272 + kk * 32); st[kt] = __builtin_amdgcn_mfma_f32_32x32x16_bf16(kf, qf[kk], st[kt], 0, 0, 0); }
        }
        float ps = 0.f;
#pragma unroll
        for (int kt = 0; kt < 2; ++kt)
#pragma unroll
            for (int i = 0; i < 16; ++i) { const float e = __builtin_amdgcn_exp2f(st[kt][i]); st[kt][i] = e; ps += e; }
        lsum += ps;
#pragma unroll
        for (int kt = 0; kt < 2; ++kt)
#pragma unroll
            for (int s = 0; s < 2; ++s) {
                u32x4 pw; pw.x = cvtpk(st[kt][8 * s], st[kt][8 * s + 1]); pw.y = cvtpk(st[kt][8 * s + 2], st[kt][8 * s + 3]); pw.z = cvtpk(st[kt][8 * s + 4], st[kt][8 * s + 5]); pw.w = cvtpk(st[kt][8 * s + 6], st[kt][8 * s + 7]);
                const bf16x8 pf = __builtin_bit_cast(bf16x8, pw);
#pragma unroll
                for (int d = 0; d < 4; ++d) {
                    const u32x4 vw = *(const u32x4*)(vb + d * 32 * 144 + (kt * 32 + 16 * s) * 2);
                    o[d] = __builtin_amdgcn_mfma_f32_32x32x16_bf16(__builtin_bit_cast(bf16x8, vw), pf, o[d], 0, 0, 0);
                }
            }
        if (j + 1 < NT) ATT_STORE(bf ^ 1);
        __syncthreads();
    }
#undef ATT_LOAD
#undef ATT_STORE
    const float ltot = lsum + __shfl_xor(lsum, 32);
    const float il = 1.0f / ltot;
    float* X = (float*)ldsg + qg * 4096;
    if (mp == 1) {
#pragma unroll
        for (int d = 0; d < 4; ++d)
#pragma unroll
            for (int g = 0; g < 4; ++g) *(f32x4*)(X + ((d * 4 + g) * 64 + lane) * 4) = (f32x4){o[d][4 * g] * il, o[d][4 * g + 1] * il, o[d][4 * g + 2] * il, o[d][4 * g + 3] * il};
    }
    __syncthreads();
    if (mp == 0) {
        float ss = 0.f;
#pragma unroll
        for (int d = 0; d < 4; ++d)
#pragma unroll
            for (int g = 0; g < 4; ++g) { const f32x4 xv = *(const f32x4*)(X + ((d * 4 + g) * 64 + lane) * 4);
#pragma unroll
                for (int e = 0; e < 4; ++e) { const float c = o[d][4 * g + e] * il - lam * xv[e]; o[d][4 * g + e] = c; ss += c * c; } }
        ss += __shfl_xor(ss, 32);
        const float rs = rsqrtf(ss * (1.0f / 128.0f) + 1e-6f) * 0.8f;
        const float* sw = p.in[18];
        bf16_t* OA = (bf16_t*)((unsigned char*)p.out + (size_t)M_TOK * 2048) + (qrow0 + 32 * qg + r) * 1024 + h * 128;
#pragma unroll
        for (int d = 0; d < 4; ++d)
#pragma unroll
            for (int g = 0; g < 4; ++g) { const int dd = d * 32 + 8 * g + 4 * hh; const f32x4 w = *(const f32x4*)(sw + dd);
                store_bf4(OA + dd, o[d][4 * g] * rs * w[0], o[d][4 * g + 1] * rs * w[1], o[d][4 * g + 2] * rs * w[2], o[d][4 * g + 3] * rs * w[3]); }
    }
    __syncthreads();
}

DI void phase_post(const Params& p) {
    const int tid = threadIdx.x, lane = tid & 63, wid = __builtin_amdgcn_readfirstlane(tid >> 6);
    const bf16_t* Y = (const bf16_t*)(p.ws + OFF_H1); const float* BS = (const float*)(p.ws + OFF_BS);
    const bf16_t* Vr = (const bf16_t*)(p.ws + OFF_VR); const bf16_t* Gr = (const bf16_t*)(p.ws + OFF_GR); bf16_t* OR = (bf16_t*)((unsigned char*)p.out + (size_t)M_TOK * 2048) + 512;
    const int c0 = lane * 8, h = lane >> 3;
    f32x4 lw[2], lb[2];
#pragma unroll
    for (int j = 0; j < 2; ++j) { lw[j] = *(const f32x4*)(p.in[26] + c0 + 4 * j); lb[j] = *(const f32x4*)(p.in[27] + c0 + 4 * j); }
    for (int row = blockIdx.x * 8 + wid; row < M_TOK; row += gridDim.x * 8) {
        f32x4 y[2];
        { const u32x4 ya = *(const u32x4*)(Y + (size_t)row * 512 + c0), yb = *(const u32x4*)(Y + ((size_t)M_TOK + row) * 512 + c0);
#pragma unroll
          for (int j = 0; j < 2; ++j)
#pragma unroll
              for (int e2 = 0; e2 < 2; ++e2) { const unsigned wa = ya[2 * j + e2], wb = yb[2 * j + e2];
                  y[j][2 * e2] = __uint_as_float(wa << 16) + __uint_as_float(wb << 16); y[j][2 * e2 + 1] = __uint_as_float(wa & 0xffff0000u) + __uint_as_float(wb & 0xffff0000u); } }
        float s = (y[0][0] + y[0][1]) + (y[0][2] + y[0][3]) + (y[1][0] + y[1][1]) + (y[1][2] + y[1][3]);
        s += __shfl_xor(s, 1); s += __shfl_xor(s, 2); s += __shfl_xor(s, 4);
        const float mu = s * (1.0f / 64.0f);
        float q = 0.f;
#pragma unroll
        for (int j = 0; j < 2; ++j)
#pragma unroll
            for (int e = 0; e < 4; ++e) { const float d = y[j][e] - mu; q += d * d; }
        q += __shfl_xor(q, 1); q += __shfl_xor(q, 2); q += __shfl_xor(q, 4);
        const float rstd = rsqrtf(q * (1.0f / 64.0f) + 64e-5f);
        const float bon = BS[(size_t)row * 8 + h] + BS[((size_t)M_TOK + row) * 8 + h];
        const u32x4 vv = *(const u32x4*)(Vr + (size_t)row * 512 + c0); const u32x2 gg = *(const u32x2*)((const unsigned char*)Gr + (size_t)row * 512 + c0);
        float ov[8];
#pragma unroll
        for (int j = 0; j < 2; ++j)
#pragma unroll
            for (int e = 0; e < 4; ++e) { const int i = 4 * j + e; const unsigned vw = vv[i >> 1];
                const float v = (i & 1) ? __uint_as_float(vw & 0xffff0000u) : __uint_as_float(vw << 16);
                const float sg = (float)(((j ? gg.y : gg.x) >> (8 * e)) & 255u) * (1.0f / 255.0f);
                const float yn = (y[j][e] - mu) * rstd * lw[j][e] + lb[j][e];
                ov[i] = (yn + bon * v) * sg; }
        u32x4 w; w.x = cvtpk(ov[0], ov[1]); w.y = cvtpk(ov[2], ov[3]); w.z = cvtpk(ov[4], ov[5]); w.w = cvtpk(ov[6], ov[7]);
        *(u32x4*)(OR + (size_t)row * 1024 + c0) = w;
    }
}
template <class Epi> DI void run_gemm(unsigned char* lds, const bf16_t* A, const bf16_t* Bt, int N, int K, const Epi& E) {
    pg8::Gemm g; g.A = A; g.Bt = Bt; g.M = M_TOK; g.N = N; g.K = K;
    pg8::StaticOrder S; S.init(M_TOK, N, (int)gridDim.x, (int)blockIdx.x);
    pg8::gemm_phase<Epi, pg8::StaticOrder, true, true>((PG8_LAS unsigned char*)lds, g, S, E);
}

__global__ void __launch_bounds__(512, 2) fwd_megakernel(Params p) {
    extern __shared__ __attribute__((aligned(16))) unsigned char lds[];
    cg::grid_group grid = cg::this_grid();
    const int tid = threadIdx.x;
    volatile XLAS unsigned* xst = (volatile XLAS unsigned*)(lds + 131072 + 16);
    if (tid < 2) xst[tid] = 0u;
    __syncthreads();
    unsigned char* ws = p.ws;
    float* MOD = (float*)(ws + OFF_MOD);
    bf16_t* H1 = (bf16_t*)(ws + OFF_H1);
    phase_prep(p, lds);
    grid.sync();
    const XcdBarrier xb = xcd_barrier_post((unsigned*)(p.ws + OFF_XBAR), xst);
    phase_cachek(p);
    phase_norm<false>(p.in[0], p.in[1], nullptr, p.in[9], MOD, 0, 1, H1);
    xcd_barrier(xb);
    { Epi1 E; E.ws = ws; E.out = p.out;
      run_gemm(lds, H1, (const bf16_t*)(ws + OFF_WINT), 5888, 1024, E); }
    xcd_barrier(xb);
    { float lam;
      { const int lane = tid & 63; float a = p.in[14][lane] * p.in[15][lane], b2 = p.in[16][lane] * p.in[17][lane];
#pragma unroll
        for (int o = 32; o >= 1; o >>= 1) { a += __shfl_xor(a, o); b2 += __shfl_xor(b2, o); }
        lam = __expf(a) - __expf(b2) + 0.2f; }
      unsigned* ctr = (unsigned*)(ws + OFF_CTL);
      volatile int* wq = (volatile int*)(lds + 131072);
      int it = (int)blockIdx.x;
      for (;;) {
          if (it >= 1920) break;
          int nxt_it = 0;
          if (tid == 0) nxt_it = (int)atomicAdd(ctr, 1u) + (int)gridDim.x;
          bool is_scan, lat; int a0, a1, a2;
          if (it < 128) { is_scan = true; lat = true; a0 = it >> 4; a1 = (it >> 3) & 1; a2 = it & 7; }
          else if (it < 1152) { const int u = it - 128; is_scan = false; lat = true; a0 = u >> 7; a1 = (u >> 5) & 3; a2 = u & 31; }
          else if (it < 1664) { const int u = it - 1152; is_scan = true; lat = false; a0 = u >> 4; a1 = (u >> 3) & 1; a2 = u & 7; }
          else { const int u = it - 1664; is_scan = false; lat = false; a0 = u >> 3; a1 = (u >> 1) & 3; a2 = u & 1; }
          if (is_scan) scan_chain(p, lds, lat, a0, a1, a2); else attn_unit(p, lds, lat, a0, a1, a2, lam);
          if (tid == 0) *wq = nxt_it;
          __syncthreads();
          it = *wq;
          __syncthreads();
      } }
    xcd_barrier(xb);
    phase_post(p);
    xcd_barrier(xb);
    { EpiMerge1 E; E.G = (const unsigned char*)p.out; E.MG = (bf16_t*)(ws + OFF_MERGED);
      run_gemm(lds, (const bf16_t*)((unsigned char*)p.out + (size_t)M_TOK * 2048), (const bf16_t*)(ws + OFF_WAT), 1024, 1024, E); }
    xcd_barrier(xb);
    { EpiResid<0> E; E.xa = p.in[0]; E.xb = p.in[1]; E.out = p.out + OUT_Y; E.MOD = MOD; E.gidx = 2; E.X1b = (bf16_t*)(ws + OFF_X1B);
      run_gemm(lds, (const bf16_t*)(ws + OFF_MERGED), (const bf16_t*)(ws + OFF_WOT), 1024, 1024, E); }
    xcd_barrier(xb);
    phase_norm<true>(nullptr, nullptr, (const bf16_t*)(ws + OFF_X1B), p.in[10], MOD, 3, 4, H1);
    xcd_barrier(xb);
    { EpiSwiGLU E; E.ACT = (bf16_t*)(ws + OFF_ACT); run_gemm(lds, H1, (const bf16_t*)(ws + OFF_WFIT), 5632, 1024, E); }
    xcd_barrier(xb);
    { EpiResid<1> E; E.xa = nullptr; E.xb = nullptr; E.out = p.out + OUT_Y; E.MOD = MOD; E.gidx = 5; E.X1b = (bf16_t*)(ws + OFF_X1B);
      run_gemm(lds, (const bf16_t*)(ws + OFF_ACT), (const bf16_t*)(ws + OFF_WFOT), 1024, 2816, E); }
}

extern "C" void kernel_launch(void* const* d_in, const int* in_sizes, int n_in, void* d_out, int out_size, void* d_ws, size_t ws_size, hipStream_t stream) {
    static int grid_blocks = 0;
    if (grid_blocks == 0) {
        if (n_in != 33 || ws_size < WS_END) { fprintf(stderr, "kernel_launch: need 33 inputs and >= %zu bytes of workspace; got %d inputs, %zu bytes\n", (size_t)WS_END, n_in, ws_size); grid_blocks = -1; return; }
        int dev = 0, cus = 0, per_cu = 0;
        hipGetDevice(&dev);
        hipDeviceGetAttribute(&cus, hipDeviceAttributeMultiprocessorCount, dev);
        if (hipFuncSetAttribute((const void*)fwd_megakernel, hipFuncAttributeMaxDynamicSharedMemorySize, LDS_BYTES) != hipSuccess) fprintf(stderr, "kernel_launch: hipFuncSetAttribute failed\n");
        if (hipOccupancyMaxActiveBlocksPerMultiprocessor(&per_cu, (const void*)fwd_megakernel, 512, LDS_BYTES) != hipSuccess || per_cu < 1) { fprintf(stderr, "kernel_launch: occupancy query gives %d\n", per_cu); per_cu = 1; }
        (void)hipGetLastError();
        grid_blocks = cus;
        if (grid_blocks > cus * per_cu) grid_blocks = cus * per_cu;
    }
    if (grid_blocks < 0) return;
    Params p{};
    for (int i = 0; i < 33; ++i) p.in[i] = (const float*)d_in[i];
    p.out = (float*)d_out; p.ws = (unsigned char*)d_ws; p.ws_size = 0ull;
    void* args[] = {&p};
    hipError_t e = hipLaunchCooperativeKernel((const void*)fwd_megakernel, dim3(grid_blocks), dim3(512), args, LDS_BYTES, stream);
    if (e != hipSuccess) fprintf(stderr, "cooperative launch failed: %s (grid %d)\n", hipGetErrorString(e), grid_blocks);
}
```

```cpp
#include <hip/hip_runtime.h>
#include <hip/hip_cooperative_groups.h>
#include <cstdio>
#include <cstdint>
namespace cg = cooperative_groups;
namespace pg8 {
#define PG8_LAS __attribute__((address_space(3)))
typedef unsigned short bf16_t;
typedef short bf16x8 __attribute__((ext_vector_type(8)));
typedef float f32x4 __attribute__((ext_vector_type(4)));
typedef unsigned u32x4 __attribute__((ext_vector_type(4)));
constexpr int BM = 256, BK = 64, HALF = 128, HTB = HALF * BK * 2  , STAGE_BYTES = 8 * HTB, NXCD = 8, WGM = 8;

__host__ __device__ __forceinline__ int lds_byte(int r, int c) { const int st = (r >> 4) * 2 + (c >> 5), rr = r & 15, cc = c & 31, ob = rr * 64 + cc * 2; return st * 1024 + (ob ^ (((ob >> 9) & 1) << 5)); }
__host__ __device__ __forceinline__ void stage_rc(int b, int& R, int& C) { const int st = b / 1024, sb = b % 1024, swz = sb ^ (((sb >> 9) & 1) << 5); R = (st >> 1) * 16 + swz / 64; C = (st & 1) * 32 + (swz % 64) / 2; }
__host__ __device__ __forceinline__ int perm32(int rho) { const int n = rho >> 4, i = rho & 15; return 8 * (i >> 2) + 4 * n + (i & 3); }

struct Unit { int pm, pn; };
struct Gemm { const bf16_t* A; const bf16_t* Bt; int M, N, K; };

struct StaticOrder {
    int nM, nN, nwg, G, c;
    __host__ __device__ void init(int M, int N, int G_, int c_) { nM = M / BM; nN = N / BM; nwg = nM * nN; G = G_; c = c_; }
    __host__ __device__ bool next(int i, Unit& u) const {
        const long L = (long)i * G + c; if (L >= nwg) return false;
        int wgid = (int)L; { const int q = nwg / NXCD, r = nwg % NXCD, xcd = wgid % NXCD, off = wgid / NXCD; wgid = (xcd < r ? xcd * (q + 1) : r * (q + 1) + (xcd - r) * q) + off; }
        const int nig = WGM * nN, gid = wgid / nig, fm = gid * WGM, gsz = (nM - fm) < WGM ? (nM - fm) : WGM;
        u.pm = fm + ((wgid % nig) % gsz); u.pn = (wgid % nig) / gsz; return true;
    }
    __device__ __forceinline__ void a_ready(const Unit&) const {}
    __device__ __forceinline__ void done(const Unit&) const {}
};
__device__ __forceinline__ unsigned cvt_pk_bf16(float lo, float hi) { unsigned r; asm volatile("v_cvt_pk_bf16_f32 %0, %1, %2" : "=v"(r) : "v"(lo), "v"(hi)); return r; }
typedef float f32x2 __attribute__((ext_vector_type(2)));
template <class Epi, class Sched, bool ALIGN_EPI = false, bool SP2 = false>
__device__ __forceinline__ void gemm_phase(PG8_LAS unsigned char* lds, const Gemm g, const Sched& S, const Epi& E) {
    const int tid = threadIdx.x, wid = __builtin_amdgcn_readfirstlane(tid >> 6), lane = tid & 63, wr = wid >> 2, wc = wid & 3, fr = lane & 15, fq = lane >> 4;
    const int K = g.K, nt = K / BK;
    unsigned voffA[2], voffB[2];
#pragma unroll
    for (int i = 0; i < 2; ++i) { int R, C; stage_rc(tid * 16 + i * 8192, R, C); const int Rb = Epi::PERM ? ((R & ~31) + perm32(R & 31)) : R;
        voffA[i] = (unsigned)(R * K + C) * 2u; voffB[i] = (unsigned)(Rb * K + C) * 2u; }
    const size_t kstep = (size_t)(BK * 2);
    const size_t hstep = (size_t)HALF * K * 2;
    const size_t tstep = 2 * hstep;
    const unsigned ldsw = (unsigned)wid * 1024u;
    const int aoff = lds_byte(wr * 64 + fr, fq * 8), boff = lds_byte(wc * 32 + fr, fq * 8);
#define PG8_SA(b, h) (((b) * 2 + (h)) * HTB)
#define PG8_SB(b, h) ((4 + (b) * 2 + (h)) * HTB)
#define PG8_STAGE(bufoff, gbase, voff) do { _Pragma("unroll") for (int _i = 0; _i < 2; ++_i) \
        __builtin_amdgcn_global_load_lds((const unsigned*)((const char*)(gbase) + (voff)[_i]), (PG8_LAS unsigned*)(lds + (bufoff) + ldsw + _i * 8192), 16, 0, 0); } while (0)
#define PG8_LDA(dst, b, h) do { _Pragma("unroll") for (int m = 0; m < 4; ++m) _Pragma("unroll") for (int k = 0; k < 2; ++k) dst[m][k] = *(const PG8_LAS bf16x8*)(lds + PG8_SA(b, h) + aoff + m * 2048 + k * 1024); } while (0)
#define PG8_LDB(dst, b, h) do { _Pragma("unroll") for (int n = 0; n < 2; ++n) _Pragma("unroll") for (int k = 0; k < 2; ++k) dst[n][k] = *(const PG8_LAS bf16x8*)(lds + PG8_SB(b, h) + boff + n * 2048 + k * 1024); } while (0)
#define PG8_MMA(ai, bj, At, Bt) do { __builtin_amdgcn_s_setprio(1); _Pragma("unroll") for (int m = 0; m < 4; ++m) _Pragma("unroll") for (int n = 0; n < 2; ++n) _Pragma("unroll") for (int k = 0; k < 2; ++k) \
        acc[ai][bj][m][n] = __builtin_amdgcn_mfma_f32_16x16x32_bf16(Bt[n][k], At[m][k], acc[ai][bj][m][n], 0, 0, 0); __builtin_amdgcn_s_setprio(0); } while (0)
#define PG8_WAIT_V(n) asm volatile("s_waitcnt vmcnt(" #n ")" ::: "memory")
#define PG8_WAIT_L(n) asm volatile("s_waitcnt lgkmcnt(" #n ")" ::: "memory")
#define PG8_BAR __builtin_amdgcn_s_barrier()
#define PG8_SCHED __builtin_amdgcn_sched_barrier(0)
    Unit cur, nxt; int ui = 0;
    if (!S.next(0, cur)) return;
    f32x4 acc[2][2][4][2];
#pragma unroll
    for (int a = 0; a < 2; ++a)
#pragma unroll
        for (int b = 0; b < 2; ++b)
#pragma unroll
            for (int m = 0; m < 4; ++m)
#pragma unroll
                for (int n = 0; n < 2; ++n) acc[a][b][m][n] = (f32x4){0.f, 0.f, 0.f, 0.f};
    bf16x8 At[4][2], B0[2][2], B1[2][2];
    const char* cA = (const char*)g.A + (size_t)cur.pm * tstep; const char* cB = (const char*)g.Bt + (size_t)cur.pn * tstep;
    S.a_ready(cur);
    if constexpr (SP2) {
        PG8_STAGE(PG8_SB(0, 0), cB, voffB); PG8_STAGE(PG8_SB(0, 1), cB + hstep, voffB); PG8_STAGE(PG8_SA(0, 0), cA, voffA); PG8_STAGE(PG8_SA(0, 1), cA + hstep, voffA);
        if (wr == 1) PG8_BAR;
        PG8_WAIT_V(2); PG8_BAR;
        PG8_STAGE(PG8_SB(1, 0), cB + kstep, voffB); PG8_STAGE(PG8_SA(1, 0), cA + kstep, voffA); PG8_STAGE(PG8_SB(1, 1), cB + hstep + kstep, voffB);
        PG8_WAIT_V(6); PG8_BAR;
    } else {
        PG8_STAGE(PG8_SB(0, 0), cB, voffB); PG8_STAGE(PG8_SA(0, 0), cA, voffA); PG8_STAGE(PG8_SB(0, 1), cB + hstep, voffB); PG8_STAGE(PG8_SA(0, 1), cA + hstep, voffA);
        if (wr == 1) PG8_BAR;
        PG8_WAIT_V(4); PG8_BAR;
        PG8_STAGE(PG8_SB(1, 0), cB + kstep, voffB); PG8_STAGE(PG8_SA(1, 0), cA + kstep, voffA); PG8_STAGE(PG8_SB(1, 1), cB + hstep + kstep, voffB);
        PG8_WAIT_V(6); PG8_BAR;
    }
    for (;;) {
        const bool has_next = S.next(ui + 1, nxt);
        const char* nA = has_next ? (const char*)g.A + (size_t)nxt.pm * tstep : cA; const char* nB = has_next ? (const char*)g.Bt + (size_t)nxt.pn * tstep : cB;
        for (int t = 0; t < nt; t += 2) {
            if constexpr (Epi::MIDK) { if (t == nt / 2) E.mid(acc, cur, wr, wc, fr, fq); }
            const bool last = (t == nt - 2);
            const char* a1 = cA + (size_t)(t + 1) * kstep;
            const char* a2 = last ? nA : cA + (size_t)(t + 2) * kstep; const char* b2 = last ? nB : cB + (size_t)(t + 2) * kstep;
            const char* a3 = a2 + kstep; const char* b3 = b2 + kstep;
            if (last && has_next) S.a_ready(nxt);
            if constexpr (SP2) {
            PG8_LDB(B0, 0, 0); PG8_LDB(B1, 0, 1); PG8_SCHED; PG8_LDA(At, 0, 0); PG8_STAGE(PG8_SA(1, 1), a1 + hstep, voffA);
            PG8_WAIT_V(8); PG8_WAIT_L(0); PG8_BAR; PG8_MMA(0, 0, At, B0); PG8_MMA(0, 1, At, B1); PG8_BAR; PG8_SCHED;
            PG8_LDA(At, 0, 1); PG8_STAGE(PG8_SB(0, 0), b2, voffB); PG8_STAGE(PG8_SB(0, 1), b2 + hstep, voffB); PG8_STAGE(PG8_SA(0, 0), a2, voffA);
            PG8_WAIT_V(8); PG8_WAIT_L(0); PG8_BAR; PG8_MMA(1, 0, At, B0); PG8_MMA(1, 1, At, B1); PG8_BAR; PG8_SCHED;
            PG8_LDB(B0, 1, 0); PG8_LDB(B1, 1, 1); PG8_SCHED; PG8_LDA(At, 1, 0); PG8_STAGE(PG8_SA(0, 1), a2 + hstep, voffA);
            PG8_WAIT_V(8); PG8_WAIT_L(0); PG8_BAR; PG8_MMA(0, 0, At, B0); PG8_MMA(0, 1, At, B1); PG8_BAR; PG8_SCHED;
            PG8_LDA(At, 1, 1); PG8_STAGE(PG8_SB(1, 0), b3, voffB); PG8_STAGE(PG8_SB(1, 1), b3 + hstep, voffB); PG8_STAGE(PG8_SA(1, 0), a3, voffA);
            PG8_WAIT_V(8); PG8_WAIT_L(0); PG8_BAR; PG8_MMA(1, 0, At, B0); PG8_MMA(1, 1, At, B1); PG8_BAR; PG8_SCHED;
            } else {
            PG8_LDB(B0, 0, 0); PG8_SCHED; PG8_LDA(At, 0, 0); PG8_STAGE(PG8_SA(1, 1), a1 + hstep, voffA);
            PG8_WAIT_L(8); PG8_BAR; PG8_WAIT_L(0); PG8_MMA(0, 0, At, B0); PG8_BAR; PG8_SCHED;
            PG8_LDB(B1, 0, 1); PG8_STAGE(PG8_SB(0, 0), b2, voffB);
            PG8_BAR; PG8_WAIT_L(0); PG8_MMA(0, 1, At, B1); PG8_BAR;
            PG8_LDA(At, 0, 1); PG8_STAGE(PG8_SA(0, 0), a2, voffA);
            PG8_BAR; PG8_WAIT_L(0); PG8_MMA(1, 0, At, B0); PG8_BAR; PG8_SCHED;
            PG8_STAGE(PG8_SB(0, 1), b2 + hstep, voffB);
            PG8_WAIT_V(6); PG8_BAR; PG8_MMA(1, 1, At, B1); PG8_BAR;
            PG8_LDB(B0, 1, 0); PG8_SCHED; PG8_LDA(At, 1, 0); PG8_STAGE(PG8_SA(0, 1), a2 + hstep, voffA);
            PG8_WAIT_L(8); PG8_BAR; PG8_WAIT_L(0); PG8_MMA(0, 0, At, B0); PG8_BAR; PG8_SCHED;
            PG8_LDB(B1, 1, 1); PG8_STAGE(PG8_SB(1, 0), b3, voffB);
            PG8_BAR; PG8_WAIT_L(0); PG8_MMA(0, 1, At, B1); PG8_BAR;
            PG8_LDA(At, 1, 1); PG8_STAGE(PG8_SA(1, 0), a3, voffA);
            PG8_BAR; PG8_WAIT_L(0); PG8_MMA(1, 0, At, B0); PG8_BAR; PG8_SCHED;
            PG8_STAGE(PG8_SB(1, 1), b3 + hstep, voffB);
            PG8_WAIT_V(6); PG8_BAR; PG8_MMA(1, 1, At, B1); PG8_BAR;
            }
        }
        if constexpr (ALIGN_EPI) { if (wr == 0) PG8_BAR; }
        if constexpr (!Epi::AFTER_DRAIN) { E(acc, cur, wr, wc, fr, fq); S.done(cur); }
        if (!has_next) break;
#pragma unroll
        for (int a = 0; a < 2; ++a)
#pragma unroll
            for (int b = 0; b < 2; ++b)
#pragma unroll
                for (int m = 0; m < 4; ++m)
#pragma unroll
                    for (int n = 0; n < 2; ++n) acc[a][b][m][n] = (f32x4){0.f, 0.f, 0.f, 0.f};
        cur = nxt; cA = nA; cB = nB; ++ui;
        if constexpr (ALIGN_EPI) { if (wr == 1) PG8_BAR; }
    }
    PG8_WAIT_V(0);
    if constexpr (!ALIGN_EPI) { if (wr == 0) PG8_BAR; }
    PG8_BAR;
    if constexpr (Epi::AFTER_DRAIN) { E.fused(acc, cur, wr, wc, fr, fq, lds, wid, lane); S.done(cur); }
#undef PG8_SA
#undef PG8_SB
#undef PG8_STAGE
#undef PG8_LDA
#undef PG8_LDB
#undef PG8_MMA
#undef PG8_WAIT_V
#undef PG8_WAIT_L
#undef PG8_BAR
#undef PG8_SCHED
}
}
using pg8::bf16_t; using pg8::f32x4; using pg8::Unit;
typedef short bf16x8 __attribute__((ext_vector_type(8)));
typedef float f32x16 __attribute__((ext_vector_type(16)));
typedef float f32x2_t __attribute__((ext_vector_type(2)));
typedef __bf16 bf16x2_t __attribute__((ext_vector_type(2)));
typedef unsigned u32x2 __attribute__((ext_vector_type(2)));
typedef unsigned u32x4 __attribute__((ext_vector_type(4)));
#define DI __device__ __forceinline__

constexpr int M_TOK = 40960, M_CTX = 8192;
constexpr float LOG2E = 1.4426950408889634f;

constexpr size_t al256(size_t x) { return (x + 255) & ~(size_t)255; }
constexpr size_t OFF_CTL = 0;
constexpr size_t OFF_KMAX = 2048;
constexpr size_t OFF_MOD = 4096;
constexpr size_t OFF_QKW = 1024;
constexpr size_t OFF_WINT = al256(OFF_MOD + 9 * 6144 * 4);
constexpr size_t OFF_WAT = OFF_WINT + (size_t)5888 * 1024 * 2;
constexpr size_t OFF_WRT = OFF_WAT + (size_t)1024 * 512 * 2;
constexpr size_t OFF_WOT = OFF_WRT + (size_t)1024 * 512 * 2;
constexpr size_t OFF_WFIT = OFF_WOT + (size_t)1024 * 1024 * 2;
constexpr size_t OFF_WFOT = OFF_WFIT + (size_t)5632 * 1024 * 2;
constexpr size_t OFF_WUPT = OFF_WFOT + (size_t)1024 * 2816 * 2;
constexpr size_t OFF_BS = OFF_WUPT + (size_t)4 * 512 * 64 * 2;
constexpr size_t OFF_H1 = al256(OFF_BS + (size_t)2 * M_TOK * 8 * 4);
constexpr size_t OFF_QB = OFF_H1 + (size_t)M_TOK * 1024 * 2;
constexpr size_t OFF_OA = OFF_QB + (size_t)M_TOK * 512 * 2;
constexpr size_t OFF_KC = OFF_OA + (size_t)M_TOK * 512 * 2;
constexpr size_t OFF_KL = OFF_KC + (size_t)32 * 256 * 512 * 2;
constexpr size_t OFF_VTC = OFF_KL + (size_t)8 * 4352 * 512 * 2;
constexpr size_t OFF_VTL = OFF_VTC + (size_t)32 * 4 * 128 * 256 * 2;
constexpr size_t OFF_R = OFF_VTL + (size_t)8 * 4 * 128 * 4352 * 2;
constexpr size_t OFF_KR = OFF_R + (size_t)M_TOK * 512 * 2;
constexpr size_t OFF_VR = OFF_KR + (size_t)M_TOK * 512 * 2;
constexpr size_t OFF_GR = OFF_VR + (size_t)M_TOK * 512 * 2;
constexpr size_t OFF_WLAL = OFF_GR + (size_t)M_TOK * 512 * 2;
constexpr size_t OFF_T2X = OFF_WLAL + (size_t)M_TOK * 256 * 2;
constexpr size_t OFF_XBAR = al256(OFF_T2X);
constexpr size_t WS_END = OFF_XBAR + 3456 * 4;
constexpr size_t OFF_OR = OFF_QB;
constexpr size_t OFF_T2 = OFF_R;
constexpr size_t OFF_MERGED = OFF_KC;
constexpr size_t OFF_ACT = OFF_QB;
constexpr size_t OFF_X1B = OFF_R + ((size_t)64 << 20);
static_assert(OFF_ACT + (size_t)M_TOK * 2816 * 2 <= OFF_X1B && OFF_X1B + (size_t)M_TOK * 1024 * 2 <= OFF_WLAL, "x1 placement");
static_assert(OFF_MERGED + (size_t)M_TOK * 1024 * 2 <= OFF_R, "merged overlay");
static_assert(OFF_ACT + (size_t)M_TOK * 2816 * 2 <= OFF_WLAL, "act overlay");
constexpr size_t OUT_Y = 0, OUT_NEWK = (size_t)M_TOK * 1024, OUT_NEWV = OUT_NEWK + (size_t)M_CTX * 512, OUT_STATE = OUT_NEWV + (size_t)M_CTX * 512;
constexpr int LDS_BYTES = 131072 + 256;

struct Params { const float* in[33]; float* out; unsigned char* ws; unsigned long long ws_size; };

DI float bf2f(unsigned short v) { return __uint_as_float(((unsigned)v) << 16); }
DI unsigned cvtpk(float lo, float hi) { f32x2_t v = {lo, hi}; bf16x2_t b = __builtin_convertvector(v, bf16x2_t); return __builtin_bit_cast(unsigned, b); }
DI unsigned short f2bf(float f) { return (unsigned short)(cvtpk(f, 0.f) & 0xffffu); }
DI float sigmoidf_(float x) { return __builtin_amdgcn_rcpf(1.0f + __builtin_amdgcn_exp2f(-x * LOG2E)); }
DI float tanhf_(float x) { return 1.0f - 2.0f * __builtin_amdgcn_rcpf(__builtin_amdgcn_exp2f(2.0f * LOG2E * x) + 1.0f); }
DI void store_bf4(bf16_t* p, float a, float b, float c, float d) { u32x2 w; w.x = cvtpk(a, b); w.y = cvtpk(c, d); *(u32x2*)p = w; }
DI void store_bf8(bf16_t* p, const f32x4 a, const f32x4 b) { u32x4 w; w.x = cvtpk(a[0], a[1]); w.y = cvtpk(a[2], a[3]); w.z = cvtpk(b[0], b[1]); w.w = cvtpk(b[2], b[3]); *(u32x4*)p = w; }
DI int cond_of_row(int row) { return row < M_CTX ? 8 : ((row - M_CTX) >> 12); }

DI int perm8(int p32) { return ((p32 >> 2) & 3) * 8 + (p32 >> 4) * 4 + (p32 & 3); }
DI int colmap(int mode, int n) {
    if (mode == 1) { if (n < 1024) { const int p = n & 255; return (n & ~255) + 64 * ((p >> 5) & 3) + 32 * (p >> 7) + (p & 31); }
                     if (n >= 1536) return (n & ~31) + perm8(n & 31);
                     return n; }
    if (mode == 2) { const int j = n >> 8, r = n & 255, q = (r & ~31) + perm8(r & 31); return (q < 128) ? 128 * j + q : 2816 + 128 * j + (q - 128); }
    if (mode == 3) return (n & ~31) + perm8(n & 31);
    return n;
}
DI void transpose_load(const float* src, int src_ld, int k0, int n0, int mode, float* tile) {
    const int tid = threadIdx.x, j = tid & 63, i0 = tid >> 6; const int sc = colmap(mode, n0 + j);
#pragma unroll
    for (int ps = 0; ps < 8; ++ps) { const int i = i0 + 8 * ps; tile[i * 65 + j] = src[(size_t)(k0 + i) * src_ld + sc]; }
}
DI float wscale(int mode, int n) {
    if (mode == 2) return ((n & 255) < 128) ? LOG2E : (1.0f / LOG2E);
    if (mode == 1) return (n >= 3840 || (n >= 3072 && n < 3584)) ? LOG2E : 1.0f;
    return 1.0f;
}
DI float sig2_(float x) { return __builtin_amdgcn_rcpf(1.0f + __builtin_amdgcn_exp2f(-x)); }
DI void transpose_store(bf16_t* dst, int dst_ld, int k0, int n0, const float* tile, int mode) {
    const int tid = threadIdx.x, ii = tid & 63, j0 = tid >> 6;
#pragma unroll
    for (int ps = 0; ps < 8; ++ps) { const int jj = j0 + 8 * ps; dst[(size_t)(n0 + jj) * dst_ld + k0 + ii] = f2bf(tile[ii * 65 + jj] * wscale(mode, n0 + jj)); }
}
struct TTask { const float* src; bf16_t* dst; int src_ld, dst_ld, k0, n0, mode; };
DI TTask transpose_task(const Params& p, int t) {
    TTask q; q.mode = 0;
    if (t < 1472) { q.src = p.in[11]; q.src_ld = 5888; q.dst = (bf16_t*)(p.ws + OFF_WINT); q.dst_ld = 1024; q.k0 = (t & 15) * 64; q.n0 = (t >> 4) * 64; q.mode = 1; }
    else if ((t -= 1472) < 128) { q.src = p.in[28]; q.src_ld = 1024; q.mode = 3; q.dst = (bf16_t*)(p.ws + OFF_WAT); q.dst_ld = 1024; q.k0 = (t & 7) * 64; q.n0 = (t >> 3) * 64; }
    else if ((t -= 128) < 128) { q.src = p.in[29]; q.src_ld = 1024; q.mode = 3; q.dst = (bf16_t*)(p.ws + OFF_WAT) + 512; q.dst_ld = 1024; q.k0 = (t & 7) * 64; q.n0 = (t >> 3) * 64; }
    else if ((t -= 128) < 256) { q.src = p.in[30]; q.src_ld = 1024; q.mode = 3; q.dst = (bf16_t*)(p.ws + OFF_WOT); q.dst_ld = 1024; q.k0 = (t & 15) * 64; q.n0 = (t >> 4) * 64; }
    else if ((t -= 256) < 1408) { q.src = p.in[31]; q.src_ld = 5632; q.dst = (bf16_t*)(p.ws + OFF_WFIT); q.dst_ld = 1024; q.k0 = (t & 15) * 64; q.n0 = (t >> 4) * 64; q.mode = 2; }
    else if ((t -= 1408) < 704) { q.src = p.in[32]; q.src_ld = 1024; q.mode = 3; q.dst = (bf16_t*)(p.ws + OFF_WFOT); q.dst_ld = 2816; q.k0 = (t % 44) * 64; q.n0 = (t / 44) * 64; }
    else if ((t -= 704) < 32) { const int tz = t >> 3; q.src = (tz >= 2 ? p.in[21] : p.in[19]) + (size_t)(tz & 1) * 64 * 512; q.src_ld = 512; q.dst = (bf16_t*)(p.ws + OFF_WUPT) + (size_t)tz * 512 * 64; q.dst_ld = 64; q.k0 = 0; q.n0 = (t & 7) * 64; }
    else { t -= 32; const int bh = t >> 3, b = bh >> 2, h = bh & 3; q.src = p.in[3] + (size_t)b * 256 * 512 + h * 128; q.src_ld = 512; q.dst = (bf16_t*)(p.ws + OFF_VTL) + (size_t)bh * 128 * 4352; q.dst_ld = 4352; q.k0 = (t & 3) * 64; q.n0 = ((t >> 2) & 1) * 64; }
    return q;
}
DI void phase_prep(const Params& p, unsigned char* ldsg) {
    const int tid = threadIdx.x;
    float* sl = (float*)ldsg;
    float* red = sl + 9216;
    for (int i = tid; i < 9216; i += 512) { const int c = i >> 10, k = i & 1023; const float v = (c < 8) ? p.in[5][c * 1024 + k] : p.in[6][k]; sl[i] = v * sigmoidf_(v); }
    __syncthreads();
    float* MOD = (float*)(p.ws + OFF_MOD);
    if (blockIdx.x == 0) {
        for (int i = tid; i < 1024; i += 512) ((unsigned*)(p.ws + OFF_CTL))[i] = 0u;
        for (int i = tid; i < 3456; i += 512) ((unsigned*)(p.ws + OFF_XBAR))[i] = 0u;
        __syncthreads();
        if (tid < 128) ((float*)(p.ws + OFF_QKW))[tid] = tid < 64 ? p.in[12][tid] : p.in[13][tid - 64]; }
    const float* ada_w = p.in[7]; const float* ada_b = p.in[8];
    for (int cc = blockIdx.x; cc < 256; cc += gridDim.x) {
        const int col = tid % 24, kg = tid / 24;
        float acc[9];
#pragma unroll
        for (int c = 0; c < 9; ++c) acc[c] = 0.f;
        if (tid < 504) {
            for (int k = kg; k < 1024; k += 21) { const float w = ada_w[(size_t)k * 6144 + cc * 24 + col];
#pragma unroll
                for (int c = 0; c < 9; ++c) acc[c] += sl[c * 1024 + k] * w; }
#pragma unroll
            for (int c = 0; c < 9; ++c) red[(kg * 24 + col) * 9 + c] = acc[c];
        }
        __syncthreads();
        if (tid < 216) { const int c = tid / 24, cl = tid % 24; float s = ada_b[cc * 24 + cl];
            for (int g = 0; g < 21; ++g) s += red[(g * 24 + cl) * 9 + c];
            MOD[c * 6144 + cc * 24 + cl] = s; }
        __syncthreads();
    }
    float* tile = (float*)ldsg;
    for (int task = blockIdx.x; task < 4384; task += 4 * gridDim.x) {
        TTask q[4];
#pragma unroll
        for (int e = 0; e < 4; ++e) { const int t = task + e * gridDim.x; if (t < 4384) { q[e] = transpose_task(p, t); transpose_load(q[e].src, q[e].src_ld, q[e].k0, q[e].n0, q[e].mode, tile + e * 4160); } }
        __syncthreads();
#pragma unroll
        for (int e = 0; e < 4; ++e) { const int t = task + e * gridDim.x; if (t < 4384) transpose_store(q[e].dst, q[e].dst_ld, q[e].k0, q[e].n0, tile + e * 4160, q[e].mode); }
        __syncthreads();
    }
}

DI void phase_cachek(const Params& p) {
    const int tid = threadIdx.x;
    { bf16_t* KL = (bf16_t*)(p.ws + OFF_KL); const float* ck = p.in[2];
      for (int i = blockIdx.x * 512 + tid; i < 8 * 256 * 128; i += gridDim.x * 512) {
          const int b = i >> 15, rem = i & 32767, t = rem >> 7, c4 = rem & 127;
          const f32x4 v = *(const f32x4*)(ck + (size_t)i * 4);
          store_bf4(KL + ((size_t)b * 4352 + t) * 512 + c4 * 4, v[0], v[1], v[2], v[3]);
          float ss = v[0] * v[0] + v[1] * v[1] + v[2] * v[2] + v[3] * v[3];
          ss += __shfl_xor(ss, 1); ss += __shfl_xor(ss, 2); ss += __shfl_xor(ss, 4); ss += __shfl_xor(ss, 8);
          if ((c4 & 15) == 0) atomicMax((unsigned*)(p.ws + OFF_KMAX) + b * 8 + (c4 >> 4), __float_as_uint(ss * 1.02f)); } }
}

template <bool BF16IN> DI void phase_norm(const float* xa, const float* xb, const bf16_t* xh, const float* nw, const float* MOD, int sh_idx, int sc_idx, bf16_t* H) {
    const int tid = threadIdx.x, lane = tid & 63, wid = __builtin_amdgcn_readfirstlane(tid >> 6);
    const int gw = blockIdx.x * 8 + wid, nwv = gridDim.x * 8;
    const int rpw = (M_TOK + nwv - 1) / nwv; const int r0 = gw * rpw; int r1 = r0 + rpw; if (r1 > M_TOK) r1 = M_TOK;
    int cur = -1; f32x4 scl[4], shf[4];
#pragma unroll
    for (int j = 0; j < 4; ++j) { scl[j] = (f32x4){0.f, 0.f, 0.f, 0.f}; shf[j] = scl[j]; }
    for (int row = r0; row < r1; row += 4) {
        f32x4 v[4][4];
#pragma unroll
        for (int q = 0; q < 4; ++q) { const int rr = (row + q < r1) ? row + q : r1 - 1;
            if (BF16IN) {
#pragma unroll
                for (int jj = 0; jj < 2; ++jj) { const u32x4 w = *(const u32x4*)(xh + (size_t)rr * 1024 + 8 * lane + 512 * jj);
                    v[q][2 * jj] = (f32x4){__uint_as_float(w.x << 16), __uint_as_float(w.x & 0xffff0000u), __uint_as_float(w.y << 16), __uint_as_float(w.y & 0xffff0000u)};
                    v[q][2 * jj + 1] = (f32x4){__uint_as_float(w.z << 16), __uint_as_float(w.z & 0xffff0000u), __uint_as_float(w.w << 16), __uint_as_float(w.w & 0xffff0000u)}; }
            } else { const float* x = rr < M_CTX ? xa + (size_t)rr * 1024 : xb + (size_t)(rr - M_CTX) * 1024;
#pragma unroll
                for (int j = 0; j < 4; ++j) v[q][j] = *(const f32x4*)(x + 8 * lane + 512 * (j >> 1) + 4 * (j & 1)); } }
#pragma unroll
        for (int q = 0; q < 4; ++q) { const int rr = (row + q < r1) ? row + q : r1 - 1;
            const int cid = cond_of_row(rr);
            if (cid != cur) { cur = cid;
#pragma unroll
                for (int j = 0; j < 4; ++j) { const int col = 8 * lane + 512 * (j >> 1) + 4 * (j & 1);
                    const f32x4 w = *(const f32x4*)(nw + col), sc = *(const f32x4*)(MOD + cid * 6144 + sc_idx * 1024 + col);
                    scl[j] = w * (sc + 1.0f); shf[j] = *(const f32x4*)(MOD + cid * 6144 + sh_idx * 1024 + col); } }
            float ss = 0.f;
#pragma unroll
            for (int j = 0; j < 4; ++j) ss += v[q][j][0] * v[q][j][0] + v[q][j][1] * v[q][j][1] + v[q][j][2] * v[q][j][2] + v[q][j][3] * v[q][j][3];
#pragma unroll
            for (int o = 32; o >= 1; o >>= 1) ss += __shfl_xor(ss, o);
            const float rs = rsqrtf(ss * (1.0f / 1024.0f) + 1e-6f);
#pragma unroll
            for (int jj = 0; jj < 2; ++jj) store_bf8(H + (size_t)rr * 1024 + 8 * lane + 512 * jj, v[q][2 * jj] * rs * scl[2 * jj] + shf[2 * jj], v[q][2 * jj + 1] * rs * scl[2 * jj + 1] + shf[2 * jj + 1]);
        }
    }
}
#define XB_TMO      128
#define XB_XCNT(j)  (256  + 64 * (j))
#define XB_XSUB(j)  (1280 + 64 * (j))
#define XB_XGEN(j)  (2304 + 64 * (j))
#define XB_TOP      3328
#define XB_TOPGEN   3392
#define XCD_BAR_WORDS 3456
#define XB_SPIN_CAP (1u << 18)
#define XLAS __attribute__((address_space(3)))
__device__ __forceinline__ unsigned xb_ld(unsigned* p)              { return __hip_atomic_load(p, __ATOMIC_RELAXED, __HIP_MEMORY_SCOPE_AGENT); }
__device__ __forceinline__ unsigned xb_add(unsigned* p, unsigned v) { return __hip_atomic_fetch_add(p, v, __ATOMIC_RELAXED, __HIP_MEMORY_SCOPE_AGENT); }
__device__ __forceinline__ unsigned xb_xcc_id() { return (unsigned)__builtin_amdgcn_s_getreg((3 << 11) | 20) & 0xFu; }
#define XB_SPIN(cond, bar) do { unsigned _sp = 0; while (cond) { __builtin_amdgcn_s_sleep(1); \
    if ((++_sp & 255u) == 0u) { if (xb_ld(&(bar)[XB_TMO])) break; if (_sp > XB_SPIN_CAP) { atomicAdd(&(bar)[XB_TMO], 1u); break; } } } } while (0)

struct XcdBarrier {
    unsigned* bar; unsigned x;
    volatile XLAS unsigned* st;
};

__device__ __forceinline__ XcdBarrier xcd_barrier_post(unsigned* bar, volatile XLAS unsigned* st) {
    XcdBarrier b; b.bar = bar; b.x = xb_xcc_id(); b.st = st;
    if (threadIdx.x == 0) (void)xb_add(&bar[XB_XCNT(b.x)], 1u);
    return b;
}
__device__ __forceinline__ void xcd_barrier_complete(unsigned* bar, unsigned x, unsigned& nloc, unsigned& nx) {
    const unsigned G = gridDim.x * gridDim.y * gridDim.z;
    unsigned sum, cnt, mine, sp = 0u;
    for (;;) {
        sum = 0u; cnt = 0u; mine = 0u;
#pragma unroll
        for (unsigned j = 0; j < 16; ++j) { const unsigned c = xb_ld(&bar[XB_XCNT(j)]); sum += c; cnt += (c > 0u) ? 1u : 0u; mine = (j == x) ? c : mine; }
        if (sum == G) break;
        __builtin_amdgcn_s_sleep(1);
        if ((++sp & 255u) == 0u) { if (xb_ld(&bar[XB_TMO])) break; if (sp > XB_SPIN_CAP) { atomicAdd(&bar[XB_TMO], 1u); break; } }
    }
    nloc = mine > 0u ? mine : 1u; nx = cnt > 0u ? cnt : 1u;
}

__device__ __forceinline__ void xcd_barrier(const XcdBarrier& b) {
    asm volatile("s_waitcnt vmcnt(0)" ::: "memory");
    __syncthreads();
    if (threadIdx.x == 0) {
        unsigned* bar = b.bar;
        __builtin_amdgcn_s_waitcnt(0);
        unsigned nloc = b.st[0], nx = b.st[1];
        if (nloc == 0u) { xcd_barrier_complete(bar, b.x, nloc, nx); b.st[0] = nloc; b.st[1] = nx; }
        const unsigned old = xb_add(&bar[XB_XSUB(b.x)], 1u);
        const unsigned gen = old / nloc;
        if (old + 1u == (gen + 1u) * nloc) {
            __builtin_amdgcn_fence(__ATOMIC_RELEASE, "agent");
            asm volatile("s_waitcnt vmcnt(0)" ::: "memory");
            const unsigned og = xb_add(&bar[XB_TOP], 1u);
            const unsigned tg = og / nx;
            if (og + 1u == (tg + 1u) * nx) xb_add(&bar[XB_TOPGEN], 1u);
            else XB_SPIN(xb_ld(&bar[XB_TOPGEN]) == tg, bar);
            __builtin_amdgcn_fence(__ATOMIC_ACQUIRE, "agent");
            xb_add(&bar[XB_XGEN(b.x)], 1u);
            asm volatile("s_waitcnt vmcnt(0)" ::: "memory");
        } else {
            XB_SPIN(xb_ld(&bar[XB_XGEN(b.x)]) == gen, bar);
            __builtin_amdgcn_fence(__ATOMIC_ACQUIRE, "agent");
            asm volatile("s_waitcnt vmcnt(0)" ::: "memory");
        }
    }
    __syncthreads();
}

struct Epi1 {
    static constexpr bool PERM = false, AFTER_DRAIN = false, MIDK = false;
    unsigned char* ws; float* out;
    __device__ __forceinline__ void operator()(const f32x4 (&acc)[2][2][4][2], const Unit& u, int wr, int wc, int fr, int fq) const {
        asm volatile("" : "+v"(fr), "+v"(fq));
        const int pn = u.pn, pm = u.pm; const bool ctx = pm < 32;
        bf16_t* const Qb = (bf16_t*)(ws + OFF_QB); bf16_t* const KC = (bf16_t*)(ws + OFF_KC); bf16_t* const KL = (bf16_t*)(ws + OFF_KL);
        bf16_t* const VtC = (bf16_t*)(ws + OFF_VTC); bf16_t* const VtL = (bf16_t*)(ws + OFF_VTL); bf16_t* const R = (bf16_t*)(ws + OFF_R); bf16_t* const WLAL = (bf16_t*)(ws + OFF_WLAL);
        float* const newk = out + OUT_NEWK; float* const newv = out + OUT_NEWV;
        const int lr0 = wr * 64 + fr;
        const int bL = ctx ? 0 : ((pm - 32) >> 4), tL0 = ctx ? 0 : ((pm - 32) & 15) * 256;
        if (pn < 4) {
            const bool isk = pn >= 2; const float* nw = (const float*)(ws + OFF_QKW) + (isk ? 64 : 0);
            f32x4 nwv[2][2];
#pragma unroll
            for (int bj = 0; bj < 2; ++bj)
#pragma unroll
                for (int n = 0; n < 2; ++n) nwv[bj][n] = *(const f32x4*)(nw + 32 * bj + 16 * n + 4 * fq);
            float inv[4];
#pragma unroll
            for (int e = 0; e < 4; ++e) inv[e] = __builtin_amdgcn_exp2f(-(float)(4 * fq + e) * 0.830482023721841f);
            const int colbase = 256 * (pn & 1) + 64 * wc + 4 * fq;
            float kmx = 0.f;
#pragma unroll
            for (int ai = 0; ai < 2; ++ai)
#pragma unroll
                for (int m = 0; m < 4; ++m) {
                    const int lr = lr0 + ai * 128 + m * 16;
                    float ss = 0.f;
#pragma unroll
                    for (int bj = 0; bj < 2; ++bj)
#pragma unroll
                        for (int n = 0; n < 2; ++n) { const f32x4 x = acc[ai][bj][m][n]; ss += x[0] * x[0] + x[1] * x[1] + x[2] * x[2] + x[3] * x[3]; }
                    ss += __shfl_xor(ss, 16); ss += __shfl_xor(ss, 32);
                    const float rs = rsqrtf(ss * (1.0f / 64.0f) + 1e-6f);
                    f32x4 val[2][2];
#pragma unroll
                    for (int bj = 0; bj < 2; ++bj)
#pragma unroll
                        for (int n = 0; n < 2; ++n) val[bj][n] = acc[ai][bj][m][n] * rs * nwv[bj][n];
                    if (!ctx) {
                        const int t = tL0 + lr;
#pragma unroll
                        for (int bj = 0; bj < 2; ++bj) { const float pos = (float)(bj ? (t & 63) : (t >> 6));
#pragma unroll
                            for (int e = 0; e < 4; ++e) { const float ang = pos * inv[e]; const float sn = __sinf(ang), cs = __cosf(ang);
                                const float x1 = val[bj][0][e], x2 = val[bj][1][e]; val[bj][0][e] = x1 * cs - x2 * sn; val[bj][1][e] = x1 * sn + x2 * cs; } }
                    }
                    const size_t row = (size_t)pm * 256 + lr;
                    if (isk) { float s2 = 0.f;
#pragma unroll
                        for (int bj = 0; bj < 2; ++bj)
#pragma unroll
                            for (int n = 0; n < 2; ++n) { const f32x4 v = val[bj][n]; s2 += v[0] * v[0] + v[1] * v[1] + v[2] * v[2] + v[3] * v[3]; }
                        s2 += __shfl_xor(s2, 16); s2 += __shfl_xor(s2, 32);
                        kmx = fmaxf(kmx, s2); }
#pragma unroll
                    for (int bj = 0; bj < 2; ++bj)
#pragma unroll
                        for (int n = 0; n < 2; ++n) { const int col = colbase + 32 * bj + 16 * n; const f32x4 v = val[bj][n];
                            if (!isk) { const float qsc = 0.125f * LOG2E; store_bf4(Qb + row * 512 + col, v[0] * qsc, v[1] * qsc, v[2] * qsc, v[3] * qsc); }
                            else if (ctx) { store_bf4(KC + row * 512 + col, v[0], v[1], v[2], v[3]); *(f32x4*)(newk + row * 512 + col) = v; }
                            else store_bf4(KL + ((size_t)bL * 4352 + 256 + tL0 + lr) * 512 + col, v[0], v[1], v[2], v[3]); }
                    asm volatile("" ::: "memory"); __builtin_amdgcn_sched_barrier(0);
                }
            if (isk) {
                kmx = fmaxf(kmx, __shfl_xor(kmx, 1)); kmx = fmaxf(kmx, __shfl_xor(kmx, 2)); kmx = fmaxf(kmx, __shfl_xor(kmx, 4)); kmx = fmaxf(kmx, __shfl_xor(kmx, 8));
                if (fr == 0 && fq == 0) { const int hm = 4 * (pn & 1) + wc;
                    atomicMax((unsigned*)(ws + OFF_KMAX) + (ctx ? 64 + pm * 8 : bL * 8) + hm, __float_as_uint(kmx * 1.02f)); }
            }
        } else if (pn < 6) {
#pragma unroll
            for (int ai = 0; ai < 2; ++ai)
#pragma unroll
                for (int m = 0; m < 4; ++m) { const int lr = lr0 + ai * 128 + m * 16; const size_t row = (size_t)pm * 256 + lr;
#pragma unroll
                    for (int bj = 0; bj < 2; ++bj) { const int h = 2 * (pn - 4) + bj;
#pragma unroll
                        for (int n = 0; n < 2; ++n) { const int d0 = 32 * wc + 16 * n + 4 * fq; const f32x4 v = acc[ai][bj][m][n];
                            if (ctx) { bf16_t* vp = VtC + ((size_t)(pm * 4 + h) * 128 + d0) * 256 + lr;
#pragma unroll
                                for (int e = 0; e < 4; ++e) vp[(size_t)e * 256] = f2bf(v[e]);
                                *(f32x4*)(newv + row * 512 + 256 * (pn - 4) + 128 * bj + d0) = v; }
                            else { bf16_t* vp = VtL + ((size_t)(bL * 4 + h) * 128 + d0) * 4352 + 256 + tL0 + lr;
#pragma unroll
                                for (int e = 0; e < 4; ++e) vp[(size_t)e * 4352] = f2bf(v[e]); } } }
                    asm volatile("" ::: "memory"); __builtin_amdgcn_sched_barrier(0); }
        } else if (pn < 14) {
            const int which = (pn - 6) >> 1; bf16_t* dst = R + (size_t)which * M_TOK * 512;
            const int cb = 256 * ((pn - 6) & 1) + 32 * wc + 8 * fq;
#pragma unroll
            for (int ai = 0; ai < 2; ++ai)
#pragma unroll
                for (int m = 0; m < 4; ++m) { const size_t row = (size_t)pm * 256 + lr0 + ai * 128 + m * 16;
#pragma unroll
                    for (int bj = 0; bj < 2; ++bj) {
                        if (which == 3) {
                            f32x4 t0 = acc[ai][bj][m][0], t1 = acc[ai][bj][m][1];
#pragma unroll
                            for (int e = 0; e < 4; ++e) { t0[e] = sig2_(t0[e]) * 255.0f + 0.5f; t1[e] = sig2_(t1[e]) * 255.0f + 0.5f; }
                            u32x2 w; w.x = (unsigned)t0[0] | ((unsigned)t0[1] << 8) | ((unsigned)t0[2] << 16) | ((unsigned)t0[3] << 24);
                            w.y = (unsigned)t1[0] | ((unsigned)t1[1] << 8) | ((unsigned)t1[2] << 16) | ((unsigned)t1[3] << 24);
                            *(u32x2*)((unsigned char*)dst + row * 512 + cb + 128 * bj) = w;
                        } else store_bf8(dst + row * 512 + cb + 128 * bj, acc[ai][bj][m][0], acc[ai][bj][m][1]); }
                    asm volatile("" ::: "memory"); __builtin_amdgcn_sched_barrier(0); }
        } else if (pn == 14) {
            const int cb = 32 * wc + 8 * fq;
#pragma unroll
            for (int ai = 0; ai < 2; ++ai)
#pragma unroll
                for (int m = 0; m < 4; ++m) { const size_t row = (size_t)pm * 256 + lr0 + ai * 128 + m * 16;
                    { f32x4 t0 = acc[ai][0][m][0], t1 = acc[ai][0][m][1];
#pragma unroll
                      for (int e = 0; e < 4; ++e) { t0[e] = tanhf_(t0[e]); t1[e] = tanhf_(t1[e]); }
                      store_bf8(WLAL + row * 256 + cb, t0, t1); store_bf8(WLAL + row * 256 + 128 + cb, acc[ai][1][m][0], acc[ai][1][m][1]); }
                    asm volatile("" ::: "memory"); __builtin_amdgcn_sched_barrier(0); }
        } else {
            unsigned char* const G = (unsigned char*)out; const int cb = 256 * (pn - 15) + 32 * wc + 8 * fq;
#pragma unroll
            for (int ai = 0; ai < 2; ++ai)
#pragma unroll
                for (int m = 0; m < 4; ++m) { const size_t row = (size_t)pm * 256 + lr0 + ai * 128 + m * 16;
#pragma unroll
                    for (int bj = 0; bj < 2; ++bj) { f32x4 t0 = acc[ai][bj][m][0], t1 = acc[ai][bj][m][1];
#pragma unroll
                        for (int e = 0; e < 4; ++e) { t0[e] = sig2_(t0[e]) * 255.0f + 0.5f; t1[e] = sig2_(t1[e]) * 255.0f + 0.5f; }
                        u32x2 w; w.x = (unsigned)t0[0] | ((unsigned)t0[1] << 8) | ((unsigned)t0[2] << 16) | ((unsigned)t0[3] << 24);
                        w.y = (unsigned)t1[0] | ((unsigned)t1[1] << 8) | ((unsigned)t1[2] << 16) | ((unsigned)t1[3] << 24);
                        *(u32x2*)(G + row * 2048 + cb + 128 * bj) = w; }
                    asm volatile("" ::: "memory"); __builtin_amdgcn_sched_barrier(0); }
        }
    }
};
struct EpiMerge1 {
    static constexpr bool PERM = false, AFTER_DRAIN = false, MIDK = true;
    const unsigned char* G; bf16_t* MG;
    __device__ __forceinline__ void mid(f32x4 (&acc)[2][2][4][2], const Unit& u, int wr, int wc, int fr, int fq) const {
        asm volatile("" : "+v"(fr), "+v"(fq));
        const int row0 = u.pm * 256 + wr * 64 + fr, col0 = u.pn * 256 + wc * 32 + 8 * fq;
#pragma unroll
        for (int ai = 0; ai < 2; ++ai)
#pragma unroll
            for (int m = 0; m < 4; ++m) { const unsigned char* gp = G + (size_t)(row0 + ai * 128 + m * 16) * 2048 + col0;
#pragma unroll
                for (int bj = 0; bj < 2; ++bj) { const u32x2 ga = *(const u32x2*)(gp + bj * 128), gr = *(const u32x2*)(gp + 1024 + bj * 128);
#pragma unroll
                    for (int n = 0; n < 2; ++n)
#pragma unroll
                        for (int e = 0; e < 4; ++e) { const float a = (float)(((n ? ga.y : ga.x) >> (8 * e)) & 255u), r = fmaxf((float)(((n ? gr.y : gr.x) >> (8 * e)) & 255u), 1.0f);
                            acc[ai][bj][m][n][e] *= a * __builtin_amdgcn_rcpf(r); } }
                asm volatile("" ::: "memory"); }
    }
    __device__ __forceinline__ void operator()(const f32x4 (&acc)[2][2][4][2], const Unit& u, int wr, int wc, int fr, int fq) const {
        asm volatile("" : "+v"(fr), "+v"(fq));
        const int row0 = u.pm * 256 + wr * 64 + fr, col0 = u.pn * 256 + wc * 32 + 8 * fq;
#pragma unroll
        for (int ai = 0; ai < 2; ++ai)
#pragma unroll
            for (int m = 0; m < 4; ++m) { const size_t row = (size_t)(row0 + ai * 128 + m * 16);
#pragma unroll
                for (int bj = 0; bj < 2; ++bj) { const u32x2 gr = *(const u32x2*)(G + row * 2048 + 1024 + col0 + bj * 128);
                    f32x4 o[2];
#pragma unroll
                    for (int n = 0; n < 2; ++n)
#pragma unroll
                        for (int e = 0; e < 4; ++e) o[n][e] = acc[ai][bj][m][n][e] * (fmaxf((float)(((n ? gr.y : gr.x) >> (8 * e)) & 255u), 1.0f) * (1.0f / 255.0f));
                    store_bf8(MG + row * 1024 + col0 + bj * 128, o[0], o[1]); }
                asm volatile("" ::: "memory"); }
    }
};
template <int MODE> struct EpiResid {
    static constexpr bool PERM = false, AFTER_DRAIN = false, MIDK = false;
    const float *xa, *xb; float* out; const float* MOD; int gidx; bf16_t* X1b;
    __device__ __forceinline__ void operator()(const f32x4 (&acc)[2][2][4][2], const Unit& u, int wr, int wc, int fr, int fq) const {
        asm volatile("" : "+v"(fr), "+v"(fq));
        const int row0 = u.pm * 256 + wr * 64 + fr, col0 = u.pn * 256 + wc * 32 + 8 * fq;
        const int cid = u.pm < 32 ? 8 : ((u.pm - 32) >> 4);
        f32x4 g[2][2];
#pragma unroll
        for (int bj = 0; bj < 2; ++bj)
#pragma unroll
            for (int n = 0; n < 2; ++n) g[bj][n] = *(const f32x4*)(MOD + cid * 6144 + gidx * 1024 + col0 + bj * 128 + n * 4);
#pragma unroll
        for (int ai = 0; ai < 2; ++ai)
#pragma unroll
            for (int m = 0; m < 4; ++m) { const int row = row0 + ai * 128 + m * 16; const size_t off = (size_t)row * 1024 + col0;
                const float* xs = u.pm < 32 ? xa + off : xb + (off - (size_t)M_CTX * 1024);
#pragma unroll
                for (int bj = 0; bj < 2; ++bj) { const size_t o2 = off + bj * 128;
                    if (MODE == 0) { const f32x4 x0 = *(const f32x4*)(xs + bj * 128), x1 = *(const f32x4*)(xs + bj * 128 + 4);
                        store_bf8(X1b + o2, x0 + g[bj][0] * acc[ai][bj][m][0], x1 + g[bj][1] * acc[ai][bj][m][1]); }
                    else { const u32x4 w = *(const u32x4*)(X1b + o2);
                        const f32x4 x0 = {__uint_as_float(w.x << 16), __uint_as_float(w.x & 0xffff0000u), __uint_as_float(w.y << 16), __uint_as_float(w.y & 0xffff0000u)};
                        const f32x4 x1 = {__uint_as_float(w.z << 16), __uint_as_float(w.z & 0xffff0000u), __uint_as_float(w.w << 16), __uint_as_float(w.w & 0xffff0000u)};
                        *(f32x4*)(out + o2) = x0 + g[bj][0] * acc[ai][bj][m][0]; *(f32x4*)(out + o2 + 4) = x1 + g[bj][1] * acc[ai][bj][m][1]; } } }
    }
};
struct EpiSwiGLU {
    static constexpr bool PERM = false, AFTER_DRAIN = false, MIDK = false;
    bf16_t* ACT;
    __device__ __forceinline__ void operator()(const f32x4 (&acc)[2][2][4][2], const Unit& u, int wr, int wc, int fr, int fq) const {
        asm volatile("" : "+v"(fr), "+v"(fq));
        const int row0 = u.pm * 256 + wr * 64 + fr, col0 = u.pn * 128 + wc * 32 + 8 * fq;
#pragma unroll
        for (int ai = 0; ai < 2; ++ai)
#pragma unroll
            for (int m = 0; m < 4; ++m) { bf16_t* rp = ACT + (size_t)(row0 + ai * 128 + m * 16) * 2816 + col0;
                f32x4 t[2];
#pragma unroll
                for (int n = 0; n < 2; ++n) { const f32x4 a = acc[ai][0][m][n], g = acc[ai][1][m][n];
#pragma unroll
                    for (int e = 0; e < 4; ++e) t[n][e] = a[e] * sig2_(a[e]) * g[e]; }
                store_bf8(rp, t[0], t[1]); }
    }
};
template <int CTRL> DI float dpp_add(float x) { const int y = __builtin_amdgcn_update_dpp(0, __float_as_int(x), CTRL, 0xF, 0xF, true); return x + __int_as_float(y); }
DI float red16(float x) { x = dpp_add<0xB1>(x); x = dpp_add<0x4E>(x); x = dpp_add<0x141>(x); x = dpp_add<0x140>(x); return x; }
DI float dot4(const f32x4 a, const f32x4 b) { return (a[0] * b[0] + a[1] * b[1]) + (a[2] * b[2] + a[3] * b[3]); }

#define LBAR() do { asm volatile("s_waitcnt lgkmcnt(0)" ::: "memory"); __builtin_amdgcn_s_barrier(); asm volatile("" ::: "memory"); } while (0)
#define RDL(x, l) __int_as_float(__builtin_amdgcn_readlane(__float_as_int(x), (l)))
DI bf16x8 ldfrag(const bf16_t* base, int row, int pitch, int col) { return *(const bf16x8*)(base + row * pitch + col); }
DI void scan_chain(const Params& p, unsigned char* ldsg, bool latent, int b, int z, int h) {
    int tid = threadIdx.x; asm volatile("" : "+v"(tid));
    const int lane = tid & 63, wid = __builtin_amdgcn_readfirstlane(tid >> 6), l15 = lane & 15, quad = lane >> 4;
    const int T = latent ? 4096 : 256, rowbase = latent ? M_CTX + b * 4096 : b * 256, nchunk = T >> 5;
    float* AW0 = (float*)ldsg; float* AW1 = AW0 + 2048; float* CUM = AW0 + 4096;
    bf16_t* KKt = (bf16_t*)(ldsg + 24576);
    bf16_t* S0b = (bf16_t*)(ldsg + 43008);
    bf16_t* VT = (bf16_t*)(ldsg + 52224);
    bf16_t* KDT = (bf16_t*)(ldsg + 57344);
    bf16_t* BBT = (bf16_t*)(ldsg + 62464);
    bf16_t* A1T = (bf16_t*)(ldsg + 67584);
    float* A2f = (float*)(ldsg + 75264);
    float* RHSf = (float*)(ldsg + 79360);
    bf16_t* Ub = (bf16_t*)(ldsg + 88576);
    float* CL = (float*)(ldsg + 93696);
    const bf16_t* R = (const bf16_t*)(p.ws + OFF_R); const bf16_t* Kr = (const bf16_t*)(p.ws + OFF_KR); const bf16_t* Vr = (const bf16_t*)(p.ws + OFF_VR);
    const bf16_t* WLAL = (const bf16_t*)(p.ws + OFF_WLAL); const bf16_t* WUPT = (const bf16_t*)(p.ws + OFF_WUPT);
    float* BS = (float*)(p.ws + OFF_BS); bf16_t* Y = (bf16_t*)(p.ws + OFF_H1);
    const int type = wid >> 2, ntile = wid & 3;
    bf16x8 bw[2];
#pragma unroll
    for (int ks = 0; ks < 2; ++ks) bw[ks] = *(const bf16x8*)(WUPT + ((size_t)(type * 2 + z) * 512 + h * 64 + ntile * 16 + l15) * 64 + ks * 32 + quad * 8);
    const float bias0 = (type == 0 ? p.in[20] : p.in[22])[z * 512 + h * 64 + ntile * 16 + l15];
    const int te = tid >> 4, c4 = (tid & 15) * 4, hc = h * 64 + c4;
    const f32x4 kkc = *(const f32x4*)(p.in[23] + hc), kac = *(const f32x4*)(p.in[24] + hc), rkc = *(const f32x4*)(p.in[25] + hc);
    const int vt = wid >> 1, kt0 = 2 * (wid & 1);
    f32x4 S[2];
#pragma unroll
    for (int q = 0; q < 2; ++q)
#pragma unroll
        for (int j = 0; j < 4; ++j) { const int v = vt * 16 + quad * 4 + j, k = (kt0 + q) * 16 + l15;
            S[q][j] = latent ? p.in[4][((size_t)((b * 2 + z) * 8 + h)) * 4096 + v * 64 + k] : 0.f;
            S0b[v * 72 + k] = f2bf(S[q][j]); }
    bf16x8 af[2][2]; u32x2 kreg, rreg, vreg;
#define SCAN_TOK(idx) (rowbase + (z ? (T - 1 - (idx)) : (idx)))
    const long cstep = z ? -32 : 32;
    const bf16_t* pw0 = WLAL + (size_t)SCAN_TOK(l15) * 256 + type * 128 + z * 64 + quad * 8;
    const bf16_t* pw1 = WLAL + (size_t)SCAN_TOK(16 + l15) * 256 + type * 128 + z * 64 + quad * 8;
    const bf16_t* pk = Kr + (size_t)SCAN_TOK(te) * 512 + hc;
    const long offR = (long)(R - Kr), offV = (long)(Vr - Kr);
#define SCAN_PREFETCH(n) do { \
        af[0][0] = *(const bf16x8*)(pw0); af[0][1] = *(const bf16x8*)(pw0 + 32); af[1][0] = *(const bf16x8*)(pw1); af[1][1] = *(const bf16x8*)(pw1 + 32); \
        kreg = *(const u32x2*)(pk); rreg = *(const u32x2*)(pk + offR); vreg = *(const u32x2*)(pk + offV); \
        pw0 += cstep * 256; pw1 += cstep * 256; pk += cstep * 512; } while (0)
    SCAN_PREFETCH(0);
    for (int n = 0; n < nchunk; ++n) {
        int L15 = l15, QD = quad, TE = te, C4 = c4, LN = lane;
        asm volatile("" : "+v"(L15), "+v"(QD), "+v"(TE), "+v"(C4), "+v"(LN));
        { float Lv[2][4];
#pragma unroll
          for (int mt = 0; mt < 2; ++mt) { f32x4 acc = {0.f, 0.f, 0.f, 0.f};
              acc = __builtin_amdgcn_mfma_f32_16x16x32_bf16(af[mt][0], bw[0], acc, 0, 0, 0);
              acc = __builtin_amdgcn_mfma_f32_16x16x32_bf16(af[mt][1], bw[1], acc, 0, 0, 0);
#pragma unroll
              for (int j = 0; j < 4; ++j) { const float sg = sigmoidf_(acc[j] + bias0); Lv[mt][j] = type == 0 ? -0.6065306597126334f * LOG2E * sg : sg; } }
          if (type == 0) {
              float base = 0.f;
#pragma unroll
              for (int mt = 0; mt < 2; ++mt) {
                  const float p0 = Lv[mt][0], p1 = p0 + Lv[mt][1], p2 = p1 + Lv[mt][2], p3 = p2 + Lv[mt][3];
                  float sq = p3;
                  const float u1 = __shfl_up(sq, 16); if (QD >= 1) sq += u1;
                  const float u2 = __shfl_up(sq, 32); if (QD >= 2) sq += u2;
                  const float ex = base + (sq - p3);
                  const int idx = (mt * 16 + QD * 4) * 64 + ntile * 16 + L15;
                  AW0[idx] = Lv[mt][0]; AW0[idx + 64] = Lv[mt][1]; AW0[idx + 128] = Lv[mt][2]; AW0[idx + 192] = Lv[mt][3];
                  CUM[idx] = ex + p0; CUM[idx + 64] = ex + p1; CUM[idx + 128] = ex + p2; CUM[idx + 192] = ex + p3;
                  base += __shfl(sq, 48 + L15);
              }
          } else {
#pragma unroll
              for (int mt = 0; mt < 2; ++mt)
#pragma unroll
                  for (int j = 0; j < 4; ++j) AW1[(mt * 16 + QD * 4 + j) * 64 + ntile * 16 + L15] = Lv[mt][j];
          } }
        LBAR();
        { const int tok = SCAN_TOK(n * 32 + TE);
          float kv[4], rv[4];
          kv[0] = __uint_as_float(kreg.x << 16); kv[1] = __uint_as_float(kreg.x & 0xffff0000u); kv[2] = __uint_as_float(kreg.y << 16); kv[3] = __uint_as_float(kreg.y & 0xffff0000u);
          rv[0] = __uint_as_float(rreg.x << 16); rv[1] = __uint_as_float(rreg.x & 0xffff0000u); rv[2] = __uint_as_float(rreg.y << 16); rv[3] = __uint_as_float(rreg.y & 0xffff0000u);
          float qv[4]; float ss = 0.f;
#pragma unroll
          for (int e = 0; e < 4; ++e) { qv[e] = kv[e] * kkc[e]; ss += qv[e] * qv[e]; }
          ss = red16(ss);
          const float invn = rsqrtf(fmaxf(ss, 1e-24f));
          const f32x4 aa = *(const f32x4*)(AW1 + TE * 64 + C4), Lw = *(const f32x4*)(AW0 + TE * 64 + C4), Lc = *(const f32x4*)(CUM + TE * 64 + C4);
          float KKv[4], RRv[4], KDv[4], BBv[4], ctv[4]; float bon = 0.f;
#pragma unroll
          for (int e = 0; e < 4; ++e) { const float ct = __builtin_amdgcn_exp2f(Lc[e]), cprev = __builtin_amdgcn_exp2f(Lc[e] - Lw[e]), ic = __builtin_amdgcn_exp2f(-Lc[e]);
              const float kn = qv[e] * invn, bb = kn * aa[e], kd = kv[e] * (1.0f + (aa[e] - 1.0f) * kac[e]);
              bon += rv[e] * kd * rkc[e];
              KKv[e] = kn * cprev; RRv[e] = rv[e] * ct; KDv[e] = kd * ic; BBv[e] = bb * ic;
              ctv[e] = ct; }
          if (TE == 31) *(f32x4*)(CL + C4) = (f32x4){ctv[0], ctv[1], ctv[2], ctv[3]};
          bon = red16(bon);
          if ((tid & 15) == 0) BS[((size_t)z * M_TOK + tok) * 8 + h] = bon;
          store_bf4(KKt + TE * 72 + C4, KKv[0], KKv[1], KKv[2], KKv[3]); store_bf4(KKt + 2304 + TE * 72 + C4, RRv[0], RRv[1], RRv[2], RRv[3]);
          store_bf4(KKt + 4608 + TE * 72 + C4, KDv[0], KDv[1], KDv[2], KDv[3]); store_bf4(KKt + 6912 + TE * 72 + C4, BBv[0], BBv[1], BBv[2], BBv[3]);
#pragma unroll
          for (int e = 0; e < 4; ++e) { KDT[(C4 + e) * 40 + TE] = f2bf(KDv[e]); BBT[(C4 + e) * 40 + TE] = f2bf(-BBv[e]); }
          VT[(C4 + 0) * 40 + TE] = (bf16_t)(vreg.x & 0xffffu); VT[(C4 + 1) * 40 + TE] = (bf16_t)(vreg.x >> 16); VT[(C4 + 2) * 40 + TE] = (bf16_t)(vreg.y & 0xffffu); VT[(C4 + 3) * 40 + TE] = (bf16_t)(vreg.y >> 16); }
        if (n + 1 < nchunk) SCAN_PREFETCH(n + 1);
        LBAR();
        f32x4 P[2];
        { const int am = wid >> 1;
          const bf16_t* X = KKt + 4608 + (am & 1) * 2304; const bf16_t* Yt = KKt + (am >> 1) * 2304;
          bf16_t* AT = A1T + (am == 0 ? 0 : am == 2 ? 1280 : 2560);
          const bool strict = am < 2; const float sgn = am == 3 ? -1.0f : 1.0f;
#pragma unroll
          for (int tl = 0; tl < 2; ++tl) {
              const int it = (wid & 1) ? tl : tl, tt = (wid & 1) ? 1 - tl : tl;
              f32x4 acc = {0.f, 0.f, 0.f, 0.f};
              if (!((wid & 1) && tl == 1)) {
#pragma unroll
                  for (int ks = 0; ks < 2; ++ks) acc = __builtin_amdgcn_mfma_f32_16x16x32_bf16(ldfrag(X, it * 16 + L15, 72, ks * 32 + QD * 8), ldfrag(Yt, tt * 16 + L15, 72, ks * 32 + QD * 8), acc, 0, 0, 0);
              }
              const int t = tt * 16 + L15, i0 = it * 16 + QD * 4;
              float o[4];
#pragma unroll
              for (int j = 0; j < 4; ++j) { const int i = i0 + j; const bool keep = strict ? (i < t) : (i <= t); o[j] = keep ? acc[j] * sgn : 0.f; }
              if (am == 1) { const int tp = (t & 15) * 2 + (t >> 4); A2f[(i0 + 0) * 32 + tp] = o[0]; A2f[(i0 + 1) * 32 + tp] = o[1]; A2f[(i0 + 2) * 32 + tp] = o[2]; A2f[(i0 + 3) * 32 + tp] = o[3]; }
              else store_bf4(AT + t * 40 + i0, o[0], o[1], o[2], o[3]);
          } }
        { const int which = wid >> 2, mt = wid & 3; const bf16_t* Yt = KKt + which * 2304;
#pragma unroll
          for (int nt = 0; nt < 2; ++nt) { f32x4 acc = {0.f, 0.f, 0.f, 0.f};
#pragma unroll
              for (int ks = 0; ks < 2; ++ks) acc = __builtin_amdgcn_mfma_f32_16x16x32_bf16(ldfrag(S0b, mt * 16 + L15, 72, ks * 32 + QD * 8), ldfrag(Yt, nt * 16 + L15, 72, ks * 32 + QD * 8), acc, 0, 0, 0);
              P[nt] = acc; } }
        LBAR();
        if (wid < 4) { const int mt = wid;
#pragma unroll
            for (int nt = 0; nt < 2; ++nt) { P[nt] = __builtin_amdgcn_mfma_f32_16x16x32_bf16(ldfrag(VT, mt * 16 + L15, 40, QD * 8), ldfrag(A1T, nt * 16 + L15, 40, QD * 8), P[nt], 0, 0, 0);
#pragma unroll
                for (int j = 0; j < 4; ++j) RHSf[(mt * 16 + QD * 4 + j) * 36 + nt * 16 + L15] = P[nt][j]; } }
        else { const int mt = wid & 3;
#pragma unroll
            for (int nt = 0; nt < 2; ++nt) P[nt] = __builtin_amdgcn_mfma_f32_16x16x32_bf16(ldfrag(VT, mt * 16 + L15, 40, QD * 8), ldfrag(A1T + 1280, nt * 16 + L15, 40, QD * 8), P[nt], 0, 0, 0); }
        LBAR();
        {
            const int t16 = LN & 15, r4 = LN >> 4;
            const int rowA = wid * 8 + r4, rowB = rowA + 4;
            float aL = RHSf[rowA * 36 + t16], aH = RHSf[rowA * 36 + 16 + t16], bL = RHSf[rowB * 36 + t16], bH = RHSf[rowB * 36 + 16 + t16];
#define BC(x, i) __int_as_float(__builtin_amdgcn_update_dpp(0, __float_as_int(x), 0x150 + (i), 0xF, 0xF, true))
#define SOLVE1(i) { const f32x2_t cc = *(const f32x2_t*)(A2f + (i) * 32 + t16 * 2); const float c0 = cc.x, c1 = cc.y; const float ua = BC(aL, i), ub = BC(bL, i); \
                if ((i) < 15) { aL -= ua * c0; bL -= ub * c0; } aH -= ua * c1; bH -= ub * c1; }
#define SOLVE2(i) { const float c1 = A2f[(16 + (i)) * 32 + t16 * 2 + 1]; const float ua = BC(aH, i), ub = BC(bH, i); aH -= ua * c1; bH -= ub * c1; }
            SOLVE1(0) SOLVE1(1) SOLVE1(2) SOLVE1(3) SOLVE1(4) SOLVE1(5) SOLVE1(6) SOLVE1(7) SOLVE1(8) SOLVE1(9) SOLVE1(10) SOLVE1(11) SOLVE1(12) SOLVE1(13) SOLVE1(14) SOLVE1(15)
            SOLVE2(0) SOLVE2(1) SOLVE2(2) SOLVE2(3) SOLVE2(4) SOLVE2(5) SOLVE2(6) SOLVE2(7) SOLVE2(8) SOLVE2(9) SOLVE2(10) SOLVE2(11) SOLVE2(12) SOLVE2(13) SOLVE2(14)
#undef SOLVE1
#undef SOLVE2
#undef BC
            Ub[rowA * 40 + t16] = f2bf(aL); Ub[rowA * 40 + 16 + t16] = f2bf(aH); Ub[rowB * 40 + t16] = f2bf(bL); Ub[rowB * 40 + 16 + t16] = f2bf(bH); }
        LBAR();
        if (wid >= 4) { const int mt = wid & 3;
#pragma unroll
            for (int nt = 0; nt < 2; ++nt) {
                P[nt] = __builtin_amdgcn_mfma_f32_16x16x32_bf16(ldfrag(Ub, mt * 16 + L15, 40, QD * 8), ldfrag(A1T + 2560, nt * 16 + L15, 40, QD * 8), P[nt], 0, 0, 0);
                const int tok = SCAN_TOK(n * 32 + nt * 16 + L15);
                store_bf4(Y + ((size_t)z * M_TOK + tok) * 512 + h * 64 + mt * 16 + QD * 4, P[nt][0], P[nt][1], P[nt][2], P[nt][3]); } }
#pragma unroll
        for (int q = 0; q < 2; ++q) { const int kt = kt0 + q;
            S[q] = __builtin_amdgcn_mfma_f32_16x16x32_bf16(ldfrag(VT, vt * 16 + L15, 40, QD * 8), ldfrag(KDT, kt * 16 + L15, 40, QD * 8), S[q], 0, 0, 0);
            S[q] = __builtin_amdgcn_mfma_f32_16x16x32_bf16(ldfrag(Ub, vt * 16 + L15, 40, QD * 8), ldfrag(BBT, kt * 16 + L15, 40, QD * 8), S[q], 0, 0, 0);
            const float cl = CL[kt * 16 + L15];
#pragma unroll
            for (int j = 0; j < 4; ++j) { S[q][j] *= cl; S0b[(vt * 16 + QD * 4 + j) * 72 + kt * 16 + L15] = f2bf(S[q][j]); } }
    }
    LBAR();
    if (!latent) { float* so = p.out + OUT_STATE + ((size_t)((b * 2 + z) * 8 + h)) * 4096;
#pragma unroll
        for (int q = 0; q < 2; ++q)
#pragma unroll
            for (int j = 0; j < 4; ++j) so[(vt * 16 + quad * 4 + j) * 64 + (kt0 + q) * 16 + l15] = S[q][j]; }
    __syncthreads();
#undef SCAN_PREFETCH
#undef SCAN_TOK
}

DI void attn_unit(const Params& p, unsigned char* ldsg, bool latent, int b, int h, int qb, float lam) {
    int tid = threadIdx.x; asm volatile("" : "+v"(tid));
    const int lane = tid & 63, wid = __builtin_amdgcn_readfirstlane(tid >> 6), r = lane & 31, hh = lane >> 5, qg = wid & 3, mp = wid >> 2;
    const int Tk = latent ? 4352 : 256, NT = Tk >> 6;
    const size_t qrow0 = (size_t)(latent ? M_CTX + b * 4096 : b * 256) + qb * 128;
    const bf16_t* Qb = (const bf16_t*)(p.ws + OFF_QB);
    const bf16_t* Kg = (latent ? (const bf16_t*)(p.ws + OFF_KL) + (size_t)b * 4352 * 512 : (const bf16_t*)(p.ws + OFF_KC) + (size_t)b * 256 * 512) + h * 128;
    const bf16_t* Vg = latent ? (const bf16_t*)(p.ws + OFF_VTL) + (size_t)(b * 4 + h) * 128 * 4352 : (const bf16_t*)(p.ws + OFF_VTC) + (size_t)(b * 4 + h) * 128 * 256;
    bf16x8 qf[4];
#pragma unroll
    for (int kk = 0; kk < 4; ++kk) qf[kk] = *(const bf16x8*)(Qb + (qrow0 + 32 * qg + r) * 512 + h * 128 + mp * 64 + 16 * kk + 8 * hh);
    const int krow = tid >> 3, kch = tid & 7, vrow = tid >> 2, vch = tid & 3;
    const bf16_t* kgp = Kg + (size_t)krow * 512 + kch * 8;
    const bf16_t* vgp = Vg + (size_t)vrow * Tk + vch * 8;
    unsigned char* kl = ldsg + krow * 272 + kch * 16;
    unsigned char* vl = ldsg + 34816 + vrow * 144 + (vch >> 1) * 32 + (vch & 1) * 8;
    u32x4 kr0, kr1, vr0, vr1;
#define ATT_LOAD(j) do { kr0 = *(const u32x4*)(kgp + (size_t)(j) * 64 * 512); kr1 = *(const u32x4*)(kgp + (size_t)(j) * 64 * 512 + 64); vr0 = *(const u32x4*)(vgp + (size_t)(j) * 64); vr1 = *(const u32x4*)(vgp + (size_t)(j) * 64 + 32); } while (0)
#define ATT_STORE(bf) do { *(u32x4*)(kl + (bf) * 17408) = kr0; *(u32x4*)(kl + (bf) * 17408 + 128) = kr1; \
        *(u32x2*)(vl + (bf) * 18432) = (u32x2){vr0.x, vr0.y}; *(u32x2*)(vl + (bf) * 18432 + 16) = (u32x2){vr0.z, vr0.w}; \
        *(u32x2*)(vl + (bf) * 18432 + 64) = (u32x2){vr1.x, vr1.y}; *(u32x2*)(vl + (bf) * 18432 + 80) = (u32x2){vr1.z, vr1.w}; } while (0)
    ATT_LOAD(0);
    f32x16 o[4];
#pragma unroll
    for (int d = 0; d < 4; ++d)
#pragma unroll
        for (int i = 0; i < 16; ++i) o[d][i] = 0.f;
    float lsum = 0.f;
    const float CS = 0.125f * LOG2E;
    float mref;
    { float qs = 0.f;
#pragma unroll
      for (int kk = 0; kk < 4; ++kk)
#pragma unroll
          for (int j = 0; j < 8; ++j) { const float x = bf2f((unsigned short)qf[kk][j]); qs += x * x; }
      qs += __shfl_xor(qs, 32);
      const float kmax2 = __uint_as_float(((const unsigned*)(p.ws + OFF_KMAX))[(latent ? b * 8 : 64 + b * 8) + h * 2 + mp]);
      mref = sqrtf(qs * kmax2); }
    f32x16 negm;
#pragma unroll
    for (int i = 0; i < 16; ++i) negm[i] = -mref;
    ATT_STORE(0);
    __syncthreads();
    for (int j = 0; j < NT; ++j) {
        const int bf = j & 1;
        if (j + 1 < NT) ATT_LOAD(j + 1);
        const unsigned char* kb = ldsg + bf * 17408 + r * 272 + (mp * 64 + 8 * hh) * 2;
        const unsigned char* vb = ldsg + 34816 + bf * 18432 + r * 144 + 16 * hh;
        f32x16 st[2];
#pragma unroll
        for (int kt = 0; kt < 2; ++kt) {
            st[kt] = negm;
#pragma unroll
            for (int kk = 0; kk < 4; ++kk) { const bf16x8 kf = *(const bf16x8*)(kb + kt * 32 * 272 + kk * 32); st[kt] = __builtin_amdgcn_mfma_f32_32x32x16_bf16(kf, qf[kk], st[kt], 0, 0, 0); }
        }
        float ps = 0.f;
#pragma unroll
        for (int kt = 0; kt < 2; ++kt)
#pragma unroll
            for (int i = 0; i < 16; ++i) { const float e = __builtin_amdgcn_exp2f(st[kt][i]); st[kt][i] = e; ps += e; }
        lsum += ps;
#pragma unroll
        for (int kt = 0; kt < 2; ++kt)
#pragma unroll
            for (int s = 0; s < 2; ++s) {
                u32x4 pw; pw.x = cvtpk(st[kt][8 * s], st[kt][8 * s + 1]); pw.y = cvtpk(st[kt][8 * s + 2], st[kt][8 * s + 3]); pw.z = cvtpk(st[kt][8 * s + 4], st[kt][8 * s + 5]); pw.w = cvtpk(st[kt][8 * s + 6], st[kt][8 * s + 7]);
                const bf16x8 pf = __builtin_bit_cast(bf16x8, pw);
#pragma unroll
                for (int d = 0; d < 4; ++d) {
                    const u32x4 vw = *(const u32x4*)(vb + d * 32 * 144 + (kt * 32 + 16 * s) * 2);
                    o[d] = __builtin_amdgcn_mfma_f32_32x32x16_bf16(__builtin_bit_cast(bf16x8, vw), pf, o[d], 0, 0, 0);
                }
            }
        if (j + 1 < NT) ATT_STORE(bf ^ 1);
        __syncthreads();
    }
#undef ATT_LOAD
#undef ATT_STORE
    const float ltot = lsum + __shfl_xor(lsum, 32);
    const float il = 1.0f / ltot;
    float* X = (float*)ldsg + qg * 4096;
    if (mp == 1) {
#pragma unroll
        for (int d = 0; d < 4; ++d)
#pragma unroll
            for (int g = 0; g < 4; ++g) *(f32x4*)(X + ((d * 4 + g) * 64 + lane) * 4) = (f32x4){o[d][4 * g] * il, o[d][4 * g + 1] * il, o[d][4 * g + 2] * il, o[d][4 * g + 3] * il};
    }
    __syncthreads();
    if (mp == 0) {
        float ss = 0.f;
#pragma unroll
        for (int d = 0; d < 4; ++d)
#pragma unroll
            for (int g = 0; g < 4; ++g) { const f32x4 xv = *(const f32x4*)(X + ((d * 4 + g) * 64 + lane) * 4);
#pragma unroll
                for (int e = 0; e < 4; ++e) { const float c = o[d][4 * g + e] * il - lam * xv[e]; o[d][4 * g + e] = c; ss += c * c; } }
        ss += __shfl_xor(ss, 32);
        const float rs = rsqrtf(ss * (1.0f / 128.0f) + 1e-6f) * 0.8f;
        const float* sw = p.in[18];
        bf16_t* OA = (bf16_t*)((unsigned char*)p.out + (size_t)M_TOK * 2048) + (qrow0 + 32 * qg + r) * 1024 + h * 128;
#pragma unroll
        for (int d = 0; d < 4; ++d)
#pragma unroll
            for (int g = 0; g < 4; ++g) { const int dd = d * 32 + 8 * g + 4 * hh; const f32x4 w = *(const f32x4*)(sw + dd);
                store_bf4(OA + dd, o[d][4 * g] * rs * w[0], o[d][4 * g + 1] * rs * w[1], o[d][4 * g + 2] * rs * w[2], o[d][4 * g + 3] * rs * w[3]); }
    }
    __syncthreads();
}

DI void phase_post(const Params& p) {
    const int tid = threadIdx.x, lane = tid & 63, wid = __builtin_amdgcn_readfirstlane(tid >> 6);
    const bf16_t* Y = (const bf16_t*)(p.ws + OFF_H1); const float* BS = (const float*)(p.ws + OFF_BS);
    const bf16_t* Vr = (const bf16_t*)(p.ws + OFF_VR); const bf16_t* Gr = (const bf16_t*)(p.ws + OFF_GR); bf16_t* OR = (bf16_t*)((unsigned char*)p.out + (size_t)M_TOK * 2048) + 512;
    const int c0 = lane * 8, h = lane >> 3;
    f32x4 lw[2], lb[2];
#pragma unroll
    for (int j = 0; j < 2; ++j) { lw[j] = *(const f32x4*)(p.in[26] + c0 + 4 * j); lb[j] = *(const f32x4*)(p.in[27] + c0 + 4 * j); }
    for (int row = blockIdx.x * 8 + wid; row < M_TOK; row += gridDim.x * 8) {
        f32x4 y[2];
        { const u32x4 ya = *(const u32x4*)(Y + (size_t)row * 512 + c0), yb = *(const u32x4*)(Y + ((size_t)M_TOK + row) * 512 + c0);
#pragma unroll
          for (int j = 0; j < 2; ++j)
#pragma unroll
              for (int e2 = 0; e2 < 2; ++e2) { const unsigned wa = ya[2 * j + e2], wb = yb[2 * j + e2];
                  y[j][2 * e2] = __uint_as_float(wa << 16) + __uint_as_float(wb << 16); y[j][2 * e2 + 1] = __uint_as_float(wa & 0xffff0000u) + __uint_as_float(wb & 0xffff0000u); } }
        float s = (y[0][0] + y[0][1]) + (y[0][2] + y[0][3]) + (y[1][0] + y[1][1]) + (y[1][2] + y[1][3]);
        s += __shfl_xor(s, 1); s += __shfl_xor(s, 2); s += __shfl_xor(s, 4);
        const float mu = s * (1.0f / 64.0f);
        float q = 0.f;
#pragma unroll
        for (int j = 0; j < 2; ++j)
#pragma unroll
            for (int e = 0; e < 4; ++e) { const float d = y[j][e] - mu; q += d * d; }
        q += __shfl_xor(q, 1); q += __shfl_xor(q, 2); q += __shfl_xor(q, 4);
        const float rstd = rsqrtf(q * (1.0f / 64.0f) + 64e-5f);
        const float bon = BS[(size_t)row * 8 + h] + BS[((size_t)M_TOK + row) * 8 + h];
        const u32x4 vv = *(const u32x4*)(Vr + (size_t)row * 512 + c0); const u32x2 gg = *(const u32x2*)((const unsigned char*)Gr + (size_t)row * 512 + c0);
        float ov[8];
#pragma unroll
        for (int j = 0; j < 2; ++j)
#pragma unroll
            for (int e = 0; e < 4; ++e) { const int i = 4 * j + e; const unsigned vw = vv[i >> 1];
                const float v = (i & 1) ? __uint_as_float(vw & 0xffff0000u) : __uint_as_float(vw << 16);
                const float sg = (float)(((j ? gg.y : gg.x) >> (8 * e)) & 255u) * (1.0f / 255.0f);
                const float yn = (y[j][e] - mu) * rstd * lw[j][e] + lb[j][e];
                ov[i] = (yn + bon * v) * sg; }
        u32x4 w; w.x = cvtpk(ov[0], ov[1]); w.y = cvtpk(ov[2], ov[3]); w.z = cvtpk(ov[4], ov[5]); w.w = cvtpk(ov[6], ov[7]);
        *(u32x4*)(OR + (size_t)row * 1024 + c0) = w;
    }
}
template <class Epi> DI void run_gemm(unsigned char* lds, const bf16_t* A, const bf16_t* Bt, int N, int K, const Epi& E) {
    pg8::Gemm g; g.A = A; g.Bt = Bt; g.M = M_TOK; g.N = N; g.K = K;
    pg8::StaticOrder S; S.init(M_TOK, N, (int)gridDim.x, (int)blockIdx.x);
    pg8::gemm_phase<Epi, pg8::StaticOrder, true, true>((PG8_LAS unsigned char*)lds, g, S, E);
}

__global__ void __launch_bounds__(512, 2) fwd_megakernel(Params p) {
    extern __shared__ __attribute__((aligned(16))) unsigned char lds[];
    cg::grid_group grid = cg::this_grid();
    const int tid = threadIdx.x;
    volatile XLAS unsigned* xst = (volatile XLAS unsigned*)(lds + 131072 + 16);
    if (tid < 2) xst[tid] = 0u;
    __syncthreads();
    unsigned char* ws = p.ws;
    float* MOD = (float*)(ws + OFF_MOD);
    bf16_t* H1 = (bf16_t*)(ws + OFF_H1);
    phase_prep(p, lds);
    grid.sync();
    const XcdBarrier xb = xcd_barrier_post((unsigned*)(p.ws + OFF_XBAR), xst);
    phase_cachek(p);
    phase_norm<false>(p.in[0], p.in[1], nullptr, p.in[9], MOD, 0, 1, H1);
    xcd_barrier(xb);
    { Epi1 E; E.ws = ws; E.out = p.out;
      run_gemm(lds, H1, (const bf16_t*)(ws + OFF_WINT), 5888, 1024, E); }
    xcd_barrier(xb);
    { float lam;
      { const int lane = tid & 63; float a = p.in[14][lane] * p.in[15][lane], b2 = p.in[16][lane] * p.in[17][lane];
#pragma unroll
        for (int o = 32; o >= 1; o >>= 1) { a += __shfl_xor(a, o); b2 += __shfl_xor(b2, o); }
        lam = __expf(a) - __expf(b2) + 0.2f; }
      unsigned* ctr = (unsigned*)(ws + OFF_CTL);
      volatile int* wq = (volatile int*)(lds + 131072);
      int it = (int)blockIdx.x;
      for (;;) {
          if (it >= 1920) break;
          int nxt_it = 0;
          if (tid == 0) nxt_it = (int)atomicAdd(ctr, 1u) + (int)gridDim.x;
          bool is_scan, lat; int a0, a1, a2;
          if (it < 128) { is_scan = true; lat = true; a0 = it >> 4; a1 = (it >> 3) & 1; a2 = it & 7; }
          else if (it < 1152) { const int u = it - 128; is_scan = false; lat = true; a0 = u >> 7; a1 = (u >> 5) & 3; a2 = u & 31; }
          else if (it < 1664) { const int u = it - 1152; is_scan = true; lat = false; a0 = u >> 4; a1 = (u >> 3) & 1; a2 = u & 7; }
          else { const int u = it - 1664; is_scan = false; lat = false; a0 = u >> 3; a1 = (u >> 1) & 3; a2 = u & 1; }
          if (is_scan) scan_chain(p, lds, lat, a0, a1, a2); else attn_unit(p, lds, lat, a0, a1, a2, lam);
          if (tid == 0) *wq = nxt_it;
          __syncthreads();
          it = *wq;
          __syncthreads();
      } }
    xcd_barrier(xb);
    phase_post(p);
    xcd_barrier(xb);
    { EpiMerge1 E; E.G = (const unsigned char*)p.out; E.MG = (bf16_t*)(ws + OFF_MERGED);
      run_gemm(lds, (const bf16_t*)((unsigned char*)p.out + (size_t)M_TOK * 2048), (const bf16_t*)(ws + OFF_WAT), 1024, 1024, E); }
    xcd_barrier(xb);
    { EpiResid<0> E; E.xa = p.in[0]; E.xb = p.in[1]; E.out = p.out + OUT_Y; E.MOD = MOD; E.gidx = 2; E.X1b = (bf16_t*)(ws + OFF_X1B);
      run_gemm(lds, (const bf16_t*)(ws + OFF_MERGED), (const bf16_t*)(ws + OFF_WOT), 1024, 1024, E); }
    xcd_barrier(xb);
    phase_norm<true>(nullptr, nullptr, (const bf16_t*)(ws + OFF_X1B), p.in[10], MOD, 3, 4, H1);
    xcd_barrier(xb);
    { EpiSwiGLU E; E.ACT = (bf16_t*)(ws + OFF_ACT); run_gemm(lds, H1, (const bf16_t*)(ws + OFF_WFIT), 5632, 1024, E); }
    xcd_barrier(xb);
    { EpiResid<1> E; E.xa = nullptr; E.xb = nullptr; E.out = p.out + OUT_Y; E.MOD = MOD; E.gidx = 5; E.X1b = (bf16_t*)(ws + OFF_X1B);
      run_gemm(lds, (const bf16_t*)(ws + OFF_ACT), (const bf16_t*)(ws + OFF_WFOT), 1024, 2816, E); }
}

extern "C" void kernel_launch(void* const* d_in, const int* in_sizes, int n_in, void* d_out, int out_size, void* d_ws, size_t ws_size, hipStream_t stream) {
    static int grid_blocks = 0;
    if (grid_blocks == 0) {
        if (n_in != 33 || ws_size < WS_END) { fprintf(stderr, "kernel_launch: need 33 inputs and >= %zu bytes of workspace; got %d inputs, %zu bytes\n", (size_t)WS_END, n_in, ws_size); grid_blocks = -1; return; }
        int dev = 0, cus = 0, per_cu = 0;
        hipGetDevice(&dev);
        hipDeviceGetAttribute(&cus, hipDeviceAttributeMultiprocessorCount, dev);
        if (hipFuncSetAttribute((const void*)fwd_megakernel, hipFuncAttributeMaxDynamicSharedMemorySize, LDS_BYTES) != hipSuccess) fprintf(stderr, "kernel_launch: hipFuncSetAttribute failed\n");
        if (hipOccupancyMaxActiveBlocksPerMultiprocessor(&per_cu, (const void*)fwd_megakernel, 512, LDS_BYTES) != hipSuccess || per_cu < 1) { fprintf(stderr, "kernel_launch: occupancy query gives %d\n", per_cu); per_cu = 1; }
        (void)hipGetLastError();
        grid_blocks = cus;
        if (grid_blocks > cus * per_cu) grid_blocks = cus * per_cu;
    }
    if (grid_blocks < 0) return;
    Params p{};
    for (int i = 0; i < 33; ++i) p.in[i] = (const float*)d_in[i];
    p.out = (float*)d_out; p.ws = (unsigned char*)d_ws; p.ws_size = 0ull;
    void* args[] = {&p};
    hipError_t e = hipLaunchCooperativeKernel((const void*)fwd_megakernel, dim3(grid_blocks), dim3(512), args, LDS_BYTES, stream);
    if (e != hipSuccess) fprintf(stderr, "cooperative launch failed: %s (grid %d)\n", hipGetErrorString(e), grid_blocks);
}
```
